# Optimizing an MI355X kernel written in HIP

```python
import jax, jax.numpy as jnp
from jax import lax
import numpy as np

D_MODEL = 1024
BATCH = 4
SEQ = 4096
DEPTH = 1

HG_WIDTH = D_MODEL // 2
HG_HEAD_DIM = 128
HG_HEADS = HG_WIDTH // HG_HEAD_DIM
CONV_WIDTH = D_MODEL // 2
CONV_GROUPS = 8
CONV_K = 3
D_FF = ((-(-8 * D_MODEL // 3) + 255) // 256) * 256
CHUNK = 32
EPS = 1e-6
SPLIT_SIZES = (HG_WIDTH, HG_WIDTH, HG_WIDTH, HG_WIDTH, CONV_WIDTH, CONV_WIDTH, CONV_WIDTH, D_MODEL, D_MODEL)
N_IN = 4 * HG_WIDTH + 3 * CONV_WIDTH + 2 * D_MODEL

kernel_name = 'hybrid_hgrn2_shortconv_gated_block'


def rmsnorm(x, g):
    xf = x.astype(jnp.float32)
    y = xf * lax.rsqrt(jnp.mean(xf * xf, axis=-1, keepdims=True) + EPS)
    return (y * g.astype(jnp.float32)).astype(x.dtype)


def hgrn2_chunkwise(q, k, v, log_f):
    B, L, H, dk = q.shape
    dv = v.shape[-1]
    n = L // CHUNK

    def to_chunks(t):
        return t.reshape(B, n, CHUNK, H, t.shape[-1]).transpose(1, 0, 3, 2, 4)

    qc, kc, vc, gc = to_chunks(q), to_chunks(k), to_chunks(v), to_chunks(log_f)
    b = jnp.cumsum(gc, axis=3)
    anchor = b[:, :, :, CHUNK // 2 - 1:CHUNK // 2, :]
    q_hat = qc * jnp.exp(b - anchor)
    k_hat = kc * jnp.exp(anchor - b)
    scores = jnp.einsum('nbhid,nbhjd->nbhij', q_hat, k_hat)
    causal = jnp.tril(jnp.ones((CHUNK, CHUNK), dtype=bool))
    scores = jnp.where(causal, scores, 0.0)
    o_intra = jnp.einsum('nbhij,nbhjv->nbhiv', scores, vc)
    b_last = b[:, :, :, -1:, :]
    q_in = qc * jnp.exp(b)
    k_out = kc * jnp.exp(b_last - b)
    chunk_decay = jnp.exp(b_last[:, :, :, 0, :])

    def step(S, inp):
        q_i, k_o, v_c, dec = inp
        o = jnp.einsum('bhid,bhdv->bhiv', q_i, S)
        S = dec[..., None] * S + jnp.einsum('bhjd,bhjv->bhdv', k_o, v_c)
        return S, o

    S0 = jnp.zeros((B, H, dk, dv), jnp.float32)
    _, o_inter = lax.scan(step, S0, (q_in, k_out, vc, chunk_decay))
    o = o_intra + o_inter
    return o.transpose(1, 0, 3, 2, 4).reshape(B, L, H, dv)


def hgrn2_mixer(q_raw, f_raw, i_raw, g_raw, lb, norm_g):
    B, L, _ = q_raw.shape

    def heads(t):
        return t.reshape(B, L, HG_HEADS, HG_HEAD_DIM).astype(jnp.float32)

    q = jax.nn.silu(heads(q_raw)) * (HG_HEAD_DIM ** -0.5)
    lbh = lb.astype(jnp.float32).reshape(HG_HEADS, HG_HEAD_DIM)
    f = lbh + (1.0 - lbh) * jax.nn.sigmoid(heads(f_raw))
    o = hgrn2_chunkwise(q, 1.0 - f, heads(i_raw), jnp.log(f))
    o = rmsnorm(o, norm_g) * jax.nn.silu(heads(g_raw))
    return o.reshape(B, L, HG_WIDTH).astype(q_raw.dtype)


def short_conv_mixer(c_gate, b_gate, xb, conv_w):
    u = c_gate * xb
    rhs = conv_w.astype(u.dtype)[:, None, :]
    y = lax.conv_general_dilated(u, rhs, window_strides=(1,), padding=[(CONV_K - 1, 0)],
                                 dimension_numbers=('NWC', 'WIO', 'NWC'),
                                 feature_group_count=CONV_WIDTH)
    return b_gate * y


def swiglu(h, w_gate, w_up, w_down):
    return (jax.nn.silu(h @ w_gate) * (h @ w_up)) @ w_down


def setup_inputs(seed: int = 0) -> dict:
    key = jax.random.key(seed)
    ks = jax.random.split(key, 14)

    def nrm(k, shape, fan):
        return jax.random.normal(k, shape, jnp.float32) * (fan ** -0.5)

    def gain(k, shape):
        return 1.0 + 0.02 * jax.random.normal(k, shape, jnp.float32)

    return {
        'x': jax.random.normal(ks[0], (BATCH, SEQ, D_MODEL), jnp.float32),
        'norm_mix_g': gain(ks[1], (DEPTH, D_MODEL)),
        'w_in': nrm(ks[2], (DEPTH, D_MODEL, N_IN), D_MODEL),
        'lower_bounds': 0.1 * jax.random.normal(ks[3], (DEPTH + 1, HG_WIDTH), jnp.float32),
        'hg_norm_g': gain(ks[4], (DEPTH, HG_HEAD_DIM)),
        'conv_w': nrm(ks[5], (DEPTH, CONV_K, CONV_WIDTH), CONV_K),
        'w_branch_a': nrm(ks[6], (DEPTH, HG_WIDTH, D_MODEL), HG_WIDTH),
        'w_branch_b': nrm(ks[7], (DEPTH, CONV_WIDTH, D_MODEL), CONV_WIDTH),
        'w_out': nrm(ks[8], (DEPTH, D_MODEL, D_MODEL), D_MODEL),
        'norm_ffn_g': gain(ks[9], (DEPTH, D_MODEL)),
        'w_ffn_gate': nrm(ks[10], (DEPTH, D_MODEL, D_FF), D_MODEL),
        'w_ffn_up': nrm(ks[11], (DEPTH, D_MODEL, D_FF), D_MODEL),
        'w_ffn_down': nrm(ks[12], (DEPTH, D_FF, D_MODEL), D_FF),
        'norm_final_g': gain(ks[13], (D_MODEL,)),
    }


def reference(x, norm_mix_g, w_in, lower_bounds, hg_norm_g, conv_w, w_branch_a, w_branch_b,
              w_out, norm_ffn_g, w_ffn_gate, w_ffn_up, w_ffn_down, norm_final_g):
    offsets = [int(o) for o in np.cumsum(SPLIT_SIZES)[:-1]]
    lb_all = jnp.cumsum(jax.nn.softmax(lower_bounds.astype(jnp.float32), axis=0), axis=0)
    for l in range(DEPTH):
        h = rmsnorm(x, norm_mix_g[l])
        proj = h @ w_in[l]
        q_raw, f_raw, i_raw, g_raw, c_gate, b_gate, xb, gate_a, gate_b = jnp.split(proj, offsets, axis=-1)
        y_a = hgrn2_mixer(q_raw, f_raw, i_raw, g_raw, lb_all[l], hg_norm_g[l]) @ w_branch_a[l]
        y_b = short_conv_mixer(c_gate, b_gate, xb, conv_w[l]) @ w_branch_b[l]
        merged = jax.nn.sigmoid(gate_a) * y_a + jax.nn.sigmoid(gate_b) * y_b
        x = x + merged @ w_out[l]
        h2 = rmsnorm(x, norm_ffn_g[l])
        x = x + swiglu(h2, w_ffn_gate[l], w_ffn_up[l], w_ffn_down[l])
    return rmsnorm(x, norm_final_g)
```

```cpp
#include <hip/hip_runtime.h>
#include <hip/hip_cooperative_groups.h>
#include <cstdio>
#include <cstdint>
namespace cg = cooperative_groups;
namespace pg8 {
#define PG8_LAS __attribute__((address_space(3)))
typedef unsigned short bf16_t;
typedef short bf16x8 __attribute__((ext_vector_type(8)));
typedef float f32x4 __attribute__((ext_vector_type(4)));
typedef unsigned u32x4 __attribute__((ext_vector_type(4)));
constexpr int BM = 256, BK = 64, HALF = 128, HTB = HALF * BK * 2  , STAGE_BYTES = 8 * HTB, NXCD = 8, WGM = 8;

__host__ __device__ __forceinline__ int lds_byte(int r, int c) { const int st = (r >> 4) * 2 + (c >> 5), rr = r & 15, cc = c & 31, ob = rr * 64 + cc * 2; return st * 1024 + (ob ^ (((ob >> 9) & 1) << 5)); }
__host__ __device__ __forceinline__ void stage_rc(int b, int& R, int& C) { const int st = b / 1024, sb = b % 1024, swz = sb ^ (((sb >> 9) & 1) << 5); R = (st >> 1) * 16 + swz / 64; C = (st & 1) * 32 + (swz % 64) / 2; }
__host__ __device__ __forceinline__ int perm32(int rho) { const int n = rho >> 4, i = rho & 15; return 8 * (i >> 2) + 4 * n + (i & 3); }

struct Unit { int pm, pn, sel; };
struct Gemm { const bf16_t* A; const bf16_t* Bt; const bf16_t* A2; const bf16_t* Bt2; int M, N, K; };

struct StaticOrder {
    int nM, nN, nwg, G, c, dual;
    __host__ __device__ void init(int M, int N, int G_, int c_, int dual_ = 0) { nM = M / BM; nN = N / BM; nwg = nM * nN; G = G_; c = c_; dual = dual_; }
    __host__ __device__ bool next(int i_, Unit& u) const {
        const int i = dual ? (i_ >> 1) : i_; u.sel = dual ? (i_ & 1) : 0;
        const long L = (long)i * G + c; if (L >= nwg) return false;
        int wgid = (int)L; { const int q = nwg / NXCD, r = nwg % NXCD, xcd = wgid % NXCD, off = wgid / NXCD; wgid = (xcd < r ? xcd * (q + 1) : r * (q + 1) + (xcd - r) * q) + off; }
        const int nig = WGM * nN, gid = wgid / nig, fm = gid * WGM, gsz = (nM - fm) < WGM ? (nM - fm) : WGM;
        u.pm = fm + ((wgid % nig) % gsz); u.pn = (wgid % nig) / gsz; return true;
    }
    __device__ __forceinline__ void a_ready(const Unit&) const {}
    __device__ __forceinline__ void done(const Unit&) const {}
};

__device__ __forceinline__ unsigned cvt_pk_bf16(float lo, float hi) { unsigned r; asm volatile("v_cvt_pk_bf16_f32 %0, %1, %2" : "=v"(r) : "v"(lo), "v"(hi)); return r; }
template <class Epi, class Sched, bool ALIGN_EPI = false, bool SP2 = false>
__device__ __forceinline__ void gemm_phase(PG8_LAS unsigned char* lds, const Gemm g, const Sched& S, const Epi& E) {
    const int tid = threadIdx.x, wid = __builtin_amdgcn_readfirstlane(tid >> 6), lane = tid & 63, wr = wid >> 2, wc = wid & 3, fr = lane & 15, fq = lane >> 4;
    const int K = g.K, nt = K / BK;
    unsigned voffA[2], voffB[2];
#pragma unroll
    for (int i = 0; i < 2; ++i) { int R, C; stage_rc(tid * 16 + i * 8192, R, C); const int Rb = Epi::PERM ? ((R & ~31) + perm32(R & 31)) : R;
        voffA[i] = (unsigned)(R * K + C) * 2u; voffB[i] = (unsigned)(Rb * K + C) * 2u; }
    const size_t kstep = (size_t)(BK * 2);
    const size_t hstep = (size_t)HALF * K * 2;
    const size_t tstep = 2 * hstep;
    const unsigned ldsw = (unsigned)wid * 1024u;
    const int aoff = lds_byte(wr * 64 + fr, fq * 8), boff = lds_byte(wc * 32 + fr, fq * 8);
#define PG8_SA(b, h) (((b) * 2 + (h)) * HTB)
#define PG8_SB(b, h) ((4 + (b) * 2 + (h)) * HTB)
#define PG8_STAGE(bufoff, gbase, voff) do { _Pragma("unroll") for (int _i = 0; _i < 2; ++_i) \
        __builtin_amdgcn_global_load_lds((const unsigned*)((const char*)(gbase) + (voff)[_i]), (PG8_LAS unsigned*)(lds + (bufoff) + ldsw + _i * 8192), 16, 0, 0); } while (0)
#define PG8_LDA(dst, b, h) do { _Pragma("unroll") for (int m = 0; m < 4; ++m) _Pragma("unroll") for (int k = 0; k < 2; ++k) dst[m][k] = *(const PG8_LAS bf16x8*)(lds + PG8_SA(b, h) + aoff + m * 2048 + k * 1024); } while (0)
#define PG8_LDB(dst, b, h) do { _Pragma("unroll") for (int n = 0; n < 2; ++n) _Pragma("unroll") for (int k = 0; k < 2; ++k) dst[n][k] = *(const PG8_LAS bf16x8*)(lds + PG8_SB(b, h) + boff + n * 2048 + k * 1024); } while (0)
#define PG8_MMA(ai, bj, At, Bt) do { __builtin_amdgcn_s_setprio(1); _Pragma("unroll") for (int m = 0; m < 4; ++m) _Pragma("unroll") for (int n = 0; n < 2; ++n) _Pragma("unroll") for (int k = 0; k < 2; ++k) \
        acc[ai][bj][m][n] = __builtin_amdgcn_mfma_f32_16x16x32_bf16(Bt[n][k], At[m][k], acc[ai][bj][m][n], 0, 0, 0); __builtin_amdgcn_s_setprio(0); } while (0)
#define PG8_WAIT_V(n) asm volatile("s_waitcnt vmcnt(" #n ")" ::: "memory")
#define PG8_WAIT_L(n) asm volatile("s_waitcnt lgkmcnt(" #n ")" ::: "memory")
#define PG8_BAR __builtin_amdgcn_s_barrier()
#define PG8_SCHED __builtin_amdgcn_sched_barrier(0)
    Unit cur, nxt; int ui = 0;
    if (!S.next(0, cur)) return;
    f32x4 acc[2][2][4][2];
#pragma unroll
    for (int a = 0; a < 2; ++a)
#pragma unroll
        for (int b = 0; b < 2; ++b)
#pragma unroll
            for (int m = 0; m < 4; ++m)
#pragma unroll
                for (int n = 0; n < 2; ++n) acc[a][b][m][n] = (f32x4){0.f, 0.f, 0.f, 0.f};
    bf16x8 At[4][2], B0[2][2], B1[2][2];
    const char* cA = (const char*)(cur.sel ? g.A2 : g.A) + (size_t)cur.pm * tstep; const char* cB = (const char*)(cur.sel ? g.Bt2 : g.Bt) + (size_t)cur.pn * tstep;
    S.a_ready(cur);
    if constexpr (SP2) {
        PG8_STAGE(PG8_SB(0, 0), cB, voffB); PG8_STAGE(PG8_SB(0, 1), cB + hstep, voffB); PG8_STAGE(PG8_SA(0, 0), cA, voffA); PG8_STAGE(PG8_SA(0, 1), cA + hstep, voffA);
        if (wr == 1) PG8_BAR;
        PG8_WAIT_V(2); PG8_BAR;
        PG8_STAGE(PG8_SB(1, 0), cB + kstep, voffB); PG8_STAGE(PG8_SA(1, 0), cA + kstep, voffA); PG8_STAGE(PG8_SB(1, 1), cB + hstep + kstep, voffB);
        PG8_WAIT_V(6); PG8_BAR;
    } else {
        PG8_STAGE(PG8_SB(0, 0), cB, voffB); PG8_STAGE(PG8_SA(0, 0), cA, voffA); PG8_STAGE(PG8_SB(0, 1), cB + hstep, voffB); PG8_STAGE(PG8_SA(0, 1), cA + hstep, voffA);
        if (wr == 1) PG8_BAR;
        PG8_WAIT_V(4); PG8_BAR;
        PG8_STAGE(PG8_SB(1, 0), cB + kstep, voffB); PG8_STAGE(PG8_SA(1, 0), cA + kstep, voffA); PG8_STAGE(PG8_SB(1, 1), cB + hstep + kstep, voffB);
        PG8_WAIT_V(6); PG8_BAR;
    }
    for (;;) {
        const bool has_next = S.next(ui + 1, nxt);
        const char* nA = has_next ? (const char*)(nxt.sel ? g.A2 : g.A) + (size_t)nxt.pm * tstep : cA; const char* nB = has_next ? (const char*)(nxt.sel ? g.Bt2 : g.Bt) + (size_t)nxt.pn * tstep : cB;
        for (int t = 0; t < nt; t += 2) {
            const bool last = (t == nt - 2);
            const char* a1 = cA + (size_t)(t + 1) * kstep;
            const char* a2 = last ? nA : cA + (size_t)(t + 2) * kstep; const char* b2 = last ? nB : cB + (size_t)(t + 2) * kstep;
            const char* a3 = a2 + kstep; const char* b3 = b2 + kstep;
            if (last && has_next) S.a_ready(nxt);
            if constexpr (SP2) {
            PG8_LDB(B0, 0, 0); PG8_LDB(B1, 0, 1); PG8_SCHED; PG8_LDA(At, 0, 0); PG8_STAGE(PG8_SA(1, 1), a1 + hstep, voffA);
            PG8_WAIT_V(8); PG8_WAIT_L(0); PG8_BAR; PG8_MMA(0, 0, At, B0); PG8_MMA(0, 1, At, B1); PG8_BAR; PG8_SCHED;
            PG8_LDA(At, 0, 1); PG8_STAGE(PG8_SB(0, 0), b2, voffB); PG8_STAGE(PG8_SB(0, 1), b2 + hstep, voffB); PG8_STAGE(PG8_SA(0, 0), a2, voffA);
            PG8_WAIT_V(8); PG8_WAIT_L(0); PG8_BAR; PG8_MMA(1, 0, At, B0); PG8_MMA(1, 1, At, B1); PG8_BAR; PG8_SCHED;
            PG8_LDB(B0, 1, 0); PG8_LDB(B1, 1, 1); PG8_SCHED; PG8_LDA(At, 1, 0); PG8_STAGE(PG8_SA(0, 1), a2 + hstep, voffA);
            PG8_WAIT_V(8); PG8_WAIT_L(0); PG8_BAR; PG8_MMA(0, 0, At, B0); PG8_MMA(0, 1, At, B1); PG8_BAR; PG8_SCHED;
            PG8_LDA(At, 1, 1); PG8_STAGE(PG8_SB(1, 0), b3, voffB); PG8_STAGE(PG8_SB(1, 1), b3 + hstep, voffB); PG8_STAGE(PG8_SA(1, 0), a3, voffA);
            PG8_WAIT_V(8); PG8_WAIT_L(0); PG8_BAR; PG8_MMA(1, 0, At, B0); PG8_MMA(1, 1, At, B1); PG8_BAR; PG8_SCHED;
            } else {
            PG8_LDB(B0, 0, 0); PG8_SCHED; PG8_LDA(At, 0, 0); PG8_STAGE(PG8_SA(1, 1), a1 + hstep, voffA);
            PG8_WAIT_L(8); PG8_BAR; PG8_WAIT_L(0); PG8_MMA(0, 0, At, B0); PG8_BAR; PG8_SCHED;
            PG8_LDB(B1, 0, 1); PG8_STAGE(PG8_SB(0, 0), b2, voffB);
            PG8_BAR; PG8_WAIT_L(0); PG8_MMA(0, 1, At, B1); PG8_BAR;
            PG8_LDA(At, 0, 1); PG8_STAGE(PG8_SA(0, 0), a2, voffA);
            PG8_BAR; PG8_WAIT_L(0); PG8_MMA(1, 0, At, B0); PG8_BAR; PG8_SCHED;
            PG8_STAGE(PG8_SB(0, 1), b2 + hstep, voffB);
            PG8_WAIT_V(6); PG8_BAR; PG8_MMA(1, 1, At, B1); PG8_BAR;
            PG8_LDB(B0, 1, 0); PG8_SCHED; PG8_LDA(At, 1, 0); PG8_STAGE(PG8_SA(0, 1), a2 + hstep, voffA);
            PG8_WAIT_L(8); PG8_BAR; PG8_WAIT_L(0); PG8_MMA(0, 0, At, B0); PG8_BAR; PG8_SCHED;
            PG8_LDB(B1, 1, 1); PG8_STAGE(PG8_SB(1, 0), b3, voffB);
            PG8_BAR; PG8_WAIT_L(0); PG8_MMA(0, 1, At, B1); PG8_BAR;
            PG8_LDA(At, 1, 1); PG8_STAGE(PG8_SA(1, 0), a3, voffA);
            PG8_BAR; PG8_WAIT_L(0); PG8_MMA(1, 0, At, B0); PG8_BAR; PG8_SCHED;
            PG8_STAGE(PG8_SB(1, 1), b3 + hstep, voffB);
            PG8_WAIT_V(6); PG8_BAR; PG8_MMA(1, 1, At, B1); PG8_BAR;
            }
        }
        if constexpr (ALIGN_EPI) { if (wr == 0) PG8_BAR; }
        bool keep = false; if constexpr (!Epi::AFTER_DRAIN) { keep = E(acc, cur, wr, wc, fr, fq); S.done(cur); }
        if (!has_next) break;
        if (!keep) {
#pragma unroll
        for (int a = 0; a < 2; ++a)
#pragma unroll
            for (int b = 0; b < 2; ++b)
#pragma unroll
                for (int m = 0; m < 4; ++m)
#pragma unroll
                    for (int n = 0; n < 2; ++n) acc[a][b][m][n] = (f32x4){0.f, 0.f, 0.f, 0.f};
        }
        cur = nxt; cA = nA; cB = nB; ++ui;
        if constexpr (ALIGN_EPI) { if (wr == 1) PG8_BAR; }
    }
    PG8_WAIT_V(0);
    if constexpr (!ALIGN_EPI) { if (wr == 0) PG8_BAR; }
    PG8_BAR;
    if constexpr (Epi::AFTER_DRAIN) { E.fused(acc, cur, wr, wc, fr, fq, lds, wid, lane); S.done(cur); }
#undef PG8_SA
#undef PG8_SB
#undef PG8_STAGE
#undef PG8_LDA
#undef PG8_LDB
#undef PG8_MMA
#undef PG8_WAIT_V
#undef PG8_WAIT_L
#undef PG8_BAR
#undef PG8_SCHED
}
}

#define PG8_SP2 true
#define PG8_ALIGN true

constexpr int NWAVES = 8, NTHR = 512;
constexpr int BATCH = 4, SEQ = 4096, D = 1024, M = BATCH * SEQ, HW = 512, HD = 128, NH = 4, NIN = 5632, FF = 2816;
constexpr float EPS = 1e-6f;
constexpr int LDS_BYTES = 147456;
constexpr size_t MiB = 1u << 20;
constexpr size_t WS_SS1 = 0, WS_SS2 = 1 * MiB, WS_DSC = 2 * MiB;
constexpr size_t WS_WIN = 4 * MiB, WS_WGU = 15 * MiB, WS_WD = 26 * MiB, WS_WO = 32 * MiB, WS_WA = 34 * MiB, WS_WB = 35 * MiB;
constexpr size_t WS_Q = 36 * MiB, WS_V = 52 * MiB, WS_GS = 68 * MiB, WS_G = 84 * MiB, WS_CG = 116 * MiB, WS_BG = 132 * MiB, WS_XB = 148 * MiB, WS_GA = 164 * MiB, WS_GB = 196 * MiB, WS_SLOC = 228 * MiB;
constexpr size_t WS_CV = WS_BG, WS_HG = WS_CG, WS_MG = WS_Q, WS_XN2 = WS_G, WS_H = WS_CG, WS_END = 244 * MiB;

#define LAS __attribute__((address_space(3)))
typedef unsigned short bf16;
typedef float f32x4 __attribute__((ext_vector_type(4)));
typedef float f32x2 __attribute__((ext_vector_type(2)));
typedef float f32x16 __attribute__((ext_vector_type(16)));
typedef unsigned u32x4 __attribute__((ext_vector_type(4)));
typedef unsigned u32x2 __attribute__((ext_vector_type(2)));
typedef short bf16x8 __attribute__((ext_vector_type(8)));
typedef short s16x4 __attribute__((ext_vector_type(4)));
typedef __bf16 hbf2 __attribute__((ext_vector_type(2)));

__device__ __forceinline__ unsigned pk2(float lo, float hi) { f32x2 v = {lo, hi}; hbf2 b = __builtin_convertvector(v, hbf2); return __builtin_bit_cast(unsigned, b); }
__device__ __forceinline__ unsigned short f2bf(float f) { return (unsigned short)(pk2(f, 0.f) & 0xffffu); }
__device__ __forceinline__ float bflo(unsigned u) { return __uint_as_float(u << 16); }
__device__ __forceinline__ float bfhi(unsigned u) { return __uint_as_float(u & 0xffff0000u); }
__device__ __forceinline__ float sigm(float v) { return __fdividef(1.0f, 1.0f + __expf(-v)); }
__device__ __forceinline__ float silu(float v) { return __fdividef(v, 1.0f + __expf(-v)); }
__device__ __forceinline__ float wave_sum(float v) {
#pragma unroll
    for (int o = 1; o < 64; o <<= 1) v += __shfl_xor(v, o);
    return v;
}
#define LDS_WAIT() asm volatile("s_waitcnt lgkmcnt(0)" ::: "memory")

struct Args {
    const float *x, *norm_mix_g, *w_in, *lower_bounds, *hg_norm_g, *conv_w, *w_branch_a, *w_branch_b, *w_out, *norm_ffn_g, *w_ffn_gate, *w_ffn_up, *w_ffn_down, *norm_final_g;
    float* out; unsigned char* ws;
};

using pg8::Unit;
struct EpiProj {
    static constexpr bool PERM = true, AFTER_DRAIN = false;
    unsigned char* ws; const float* lbnd;
    __device__ __forceinline__ bool operator()(f32x4 (&acc)[2][2][4][2], const Unit& u, int wr, int wc, int fr, int fq) const {
        const int row0 = u.pm * 256 + wr * 64 + fr, pn = u.pn;
        int mode = 2, ldc = HW, colt; size_t off;
        if (pn < 2) { mode = 0; off = WS_Q; colt = pn * 256; }
        else if (pn < 4) { mode = 1; off = WS_G; colt = (pn - 2) * 256; }
        else if (pn < 6) { off = WS_V; colt = (pn - 4) * 256; }
        else if (pn < 8) { mode = 3; off = WS_GS; colt = (pn - 6) * 256; }
        else if (pn < 10) { off = WS_CG; colt = (pn - 8) * 256; }
        else if (pn < 12) { off = WS_BG; colt = (pn - 10) * 256; }
        else if (pn < 14) { off = WS_XB; colt = (pn - 12) * 256; }
        else if (pn < 18) { off = WS_GA; colt = (pn - 14) * 256; ldc = D; }
        else { off = WS_GB; colt = (pn - 18) * 256; ldc = D; }
        const int col0 = colt + wc * 32 + 8 * fq;
        if (mode == 1) {
            float* G = (float*)(ws + off);
            float lb[2][8];
#pragma unroll
            for (int bj = 0; bj < 2; ++bj)
#pragma unroll
                for (int j = 0; j < 8; ++j) { const int c = col0 + bj * 128 + j; lb[bj][j] = __fdividef(1.0f, 1.0f + __expf(lbnd[HW + c] - lbnd[c])); }
#pragma unroll
            for (int ai = 0; ai < 2; ++ai)
#pragma unroll
                for (int m = 0; m < 4; ++m) { float* rowp = G + (size_t)(row0 + ai * 128 + m * 16) * HW + col0;
#pragma unroll
                    for (int bj = 0; bj < 2; ++bj) {
#pragma unroll
                        for (int n = 0; n < 2; ++n) { f32x4 v = acc[ai][bj][m][n], o;
#pragma unroll
                            for (int e = 0; e < 4; ++e) { const float l = lb[bj][4 * n + e]; o[e] = logf(l + (1.0f - l) * sigm(v[e])); }
                            *(f32x4*)(rowp + bj * 128 + 4 * n) = o; } } }
        } else {
            bf16* O = (bf16*)(ws + off);
#pragma unroll
            for (int ai = 0; ai < 2; ++ai)
#pragma unroll
                for (int m = 0; m < 4; ++m) { bf16* rowp = O + (size_t)(row0 + ai * 128 + m * 16) * ldc + col0;
#pragma unroll
                    for (int bj = 0; bj < 2; ++bj) { f32x4 v0 = acc[ai][bj][m][0], v1 = acc[ai][bj][m][1];
                        if (mode == 0) {
#pragma unroll
                            for (int e = 0; e < 4; ++e) { v0[e] = silu(v0[e]) * 0.08838834764831845f; v1[e] = silu(v1[e]) * 0.08838834764831845f; }
                        } else if (mode == 3) {
#pragma unroll
                            for (int e = 0; e < 4; ++e) { v0[e] = silu(v0[e]); v1[e] = silu(v1[e]); }
                        }
                        u32x4 w; w.x = pk2(v0[0], v0[1]); w.y = pk2(v0[2], v0[3]); w.z = pk2(v1[0], v1[1]); w.w = pk2(v1[2], v1[3]);
                        *(u32x4*)(rowp + bj * 128) = w; } }
        }
        return false;
    }
};
struct EpiBranch {
    static constexpr bool PERM = true, AFTER_DRAIN = false;
    const bf16* GA; const bf16* GB; bf16* MG;
    __device__ __forceinline__ bool operator()(f32x4 (&acc)[2][2][4][2], const Unit& u, int wr, int wc, int fr, int fq) const {
        const int row0 = u.pm * 256 + wr * 64 + fr, col0 = u.pn * 256 + wc * 32 + 8 * fq;
        const bool first = (u.sel == 0);
#pragma unroll
        for (int ai = 0; ai < 2; ++ai)
#pragma unroll
            for (int m = 0; m < 4; ++m) { const size_t ro = (size_t)(row0 + ai * 128 + m * 16) * D + col0;
#pragma unroll
                for (int bj = 0; bj < 2; ++bj) {
                    const u32x4 gb = *(const u32x4*)(GB + ro + bj * 128);
                    float eb[8] = {bflo(gb.x), bfhi(gb.x), bflo(gb.y), bfhi(gb.y), bflo(gb.z), bfhi(gb.z), bflo(gb.w), bfhi(gb.w)};
#pragma unroll
                    for (int e = 0; e < 8; ++e) eb[e] = 1.0f + __expf(-eb[e]);
                    if (first) {
                        const u32x4 ga = *(const u32x4*)(GA + ro + bj * 128);
                        float ea[8] = {bflo(ga.x), bfhi(ga.x), bflo(ga.y), bfhi(ga.y), bflo(ga.z), bfhi(ga.z), bflo(ga.w), bfhi(ga.w)};
#pragma unroll
                        for (int e = 0; e < 8; ++e) { const float r = __fdividef(eb[e], 1.0f + __expf(-ea[e])); if (e < 4) acc[ai][bj][m][0][e] *= r; else acc[ai][bj][m][1][e - 4] *= r; }
                    } else {
                        float o[8];
#pragma unroll
                        for (int e = 0; e < 8; ++e) o[e] = __fdividef(e < 4 ? acc[ai][bj][m][0][e] : acc[ai][bj][m][1][e - 4], eb[e]);
                        u32x4 w; w.x = pk2(o[0], o[1]); w.y = pk2(o[2], o[3]); w.z = pk2(o[4], o[5]); w.w = pk2(o[6], o[7]);
                        *(u32x4*)(MG + ro + bj * 128) = w;
                    } } }
        return first;
    }
};
template <bool WITH_XN> struct EpiRes {
    static constexpr bool PERM = true, AFTER_DRAIN = false;
    const float* xi; float* xo; bf16* xn; const float* g; float* ss;
    __device__ __forceinline__ bool operator()(f32x4 (&acc)[2][2][4][2], const Unit& u, int wr, int wc, int fr, int fq) const {
        const int row0 = u.pm * 256 + wr * 64 + fr, col0 = u.pn * 256 + wc * 32 + 8 * fq;
        f32x4 gv[2][2];
        if (WITH_XN) {
#pragma unroll
            for (int bj = 0; bj < 2; ++bj)
#pragma unroll
                for (int n = 0; n < 2; ++n) gv[bj][n] = *(const f32x4*)(g + col0 + bj * 128 + 4 * n);
        }
#pragma unroll
        for (int ai = 0; ai < 2; ++ai)
#pragma unroll
            for (int m = 0; m < 4; ++m) { const int row = row0 + ai * 128 + m * 16; const size_t ro = (size_t)row * D + col0; float s = 0.f;
#pragma unroll
                for (int bj = 0; bj < 2; ++bj) {
                    const f32x4 v0 = acc[ai][bj][m][0] + *(const f32x4*)(xi + ro + bj * 128), v1 = acc[ai][bj][m][1] + *(const f32x4*)(xi + ro + bj * 128 + 4);
                    *(f32x4*)(xo + ro + bj * 128) = v0; *(f32x4*)(xo + ro + bj * 128 + 4) = v1;
                    s += (v0[0] * v0[0] + v0[1] * v0[1]) + (v0[2] * v0[2] + v0[3] * v0[3]) + (v1[0] * v1[0] + v1[1] * v1[1]) + (v1[2] * v1[2] + v1[3] * v1[3]);
                    if (WITH_XN) { const f32x4 a = v0 * gv[bj][0], b = v1 * gv[bj][1];
                        u32x4 w; w.x = pk2(a[0], a[1]); w.y = pk2(a[2], a[3]); w.z = pk2(b[0], b[1]); w.w = pk2(b[2], b[3]);
                        *(u32x4*)(xn + ro + bj * 128) = w; } }
                s += __shfl_xor(s, 16); s += __shfl_xor(s, 32);
                if (fq == 0) ss[(size_t)row * 16 + u.pn * 4 + wc] = s; }
        return false;
    }
};
struct EpiGU {
    static constexpr bool PERM = true, AFTER_DRAIN = false;
    const float* ss; bf16* H;
    __device__ __forceinline__ bool operator()(f32x4 (&acc)[2][2][4][2], const Unit& u, int wr, int wc, int fr, int fq) const {
        const int row0 = u.pm * 256 + wr * 64 + fr, col0 = u.pn * 128 + wc * 32 + 8 * fq;
#pragma unroll
        for (int ai = 0; ai < 2; ++ai)
#pragma unroll
            for (int m = 0; m < 4; ++m) { const int row = row0 + ai * 128 + m * 16;
                const f32x4* sp = (const f32x4*)(ss + (size_t)row * 16); const f32x4 s4 = (sp[0] + sp[1]) + (sp[2] + sp[3]);
                const float rstd = rsqrtf(((s4[0] + s4[1]) + (s4[2] + s4[3])) * (1.0f / D) + EPS);
                float o[8];
#pragma unroll
                for (int e = 0; e < 8; ++e) { const float gg = (e < 4 ? acc[ai][0][m][0][e] : acc[ai][0][m][1][e - 4]) * rstd, uu = (e < 4 ? acc[ai][1][m][0][e] : acc[ai][1][m][1][e - 4]) * rstd; o[e] = silu(gg) * uu; }
                u32x4 w; w.x = pk2(o[0], o[1]); w.y = pk2(o[2], o[3]); w.z = pk2(o[4], o[5]); w.w = pk2(o[6], o[7]);
                *(u32x4*)(H + (size_t)row * FF + col0) = w; }
        return false;
    }
};

__device__ __forceinline__ void transpose_item(const float* W, int K, int N, bf16* WT, int k0, int n0, int drow0, LAS float* scr, int lane) {
#pragma unroll 8
    for (int i = 0; i < 32; ++i) { const int kk = 2 * i + (lane >> 5); scr[kk * 33 + (lane & 31)] = W[(size_t)(k0 + kk) * N + n0 + (lane & 31)]; }
    LDS_WAIT(); asm volatile("" ::: "memory");
    const int c = lane & 7;
#pragma unroll
    for (int j = 0; j < 4; ++j) { const int n = (lane >> 3) + 8 * j; const LAS float* s = scr + (8 * c) * 33 + n;
        u32x4 o; o.x = pk2(s[0 * 33], s[1 * 33]); o.y = pk2(s[2 * 33], s[3 * 33]); o.z = pk2(s[4 * 33], s[5 * 33]); o.w = pk2(s[6 * 33], s[7 * 33]);
        *(u32x4*)(WT + (size_t)(drow0 + n) * K + k0 + 8 * c) = o; }
    LDS_WAIT(); asm volatile("" ::: "memory");
}
__device__ __forceinline__ void p0_prologue(const Args& a, LAS unsigned char* lds, int wave, int lane, int G) {
    LAS float* scr = (LAS float*)(lds + wave * 16384);
    const int gw = blockIdx.x * NWAVES + wave, NGW = G * NWAVES;
    unsigned char* ws = a.ws;
    constexpr int I_IN = (D / 64) * (NIN / 32), I_G = (D / 64) * (FF / 32), I_D = (FF / 64) * (D / 32), I_O = (D / 64) * (D / 32), I_A = (HW / 64) * (D / 32);
    constexpr int NITEMS = I_IN + 2 * I_G + I_D + I_O + 2 * I_A;
    for (int it = gw; it < NITEMS; it += NGW) {
        int r = it;
        if (r < I_IN) { const int nb = NIN / 32, kb = r / nb, n0 = 32 * (r % nb); transpose_item(a.w_in, D, NIN, (bf16*)(ws + WS_WIN), 64 * kb, n0, n0, scr, lane); continue; } r -= I_IN;
        if (r < I_G) { const int nb = FF / 32, kb = r / nb, n0 = 32 * (r % nb); transpose_item(a.w_ffn_gate, D, FF, (bf16*)(ws + WS_WGU), 64 * kb, n0, (n0 >> 7) * 256 + (n0 & 127), scr, lane); continue; } r -= I_G;
        if (r < I_G) { const int nb = FF / 32, kb = r / nb, n0 = 32 * (r % nb); transpose_item(a.w_ffn_up, D, FF, (bf16*)(ws + WS_WGU), 64 * kb, n0, (n0 >> 7) * 256 + 128 + (n0 & 127), scr, lane); continue; } r -= I_G;
        if (r < I_D) { const int nb = D / 32, kb = r / nb, n0 = 32 * (r % nb); transpose_item(a.w_ffn_down, FF, D, (bf16*)(ws + WS_WD), 64 * kb, n0, n0, scr, lane); continue; } r -= I_D;
        if (r < I_O) { const int nb = D / 32, kb = r / nb, n0 = 32 * (r % nb); transpose_item(a.w_out, D, D, (bf16*)(ws + WS_WO), 64 * kb, n0, n0, scr, lane); continue; } r -= I_O;
        if (r < I_A) { const int nb = D / 32, kb = r / nb, n0 = 32 * (r % nb); transpose_item(a.w_branch_a, HW, D, (bf16*)(ws + WS_WA), 64 * kb, n0, n0, scr, lane); continue; } r -= I_A;
        { const int nb = D / 32, kb = r / nb, n0 = 32 * (r % nb); transpose_item(a.w_branch_b, HW, D, (bf16*)(ws + WS_WB), 64 * kb, n0, n0, scr, lane); }
    }
    bf16* XN = (bf16*)a.out;
    f32x4 gm[4];
#pragma unroll
    for (int j = 0; j < 4; ++j) gm[j] = ((const f32x4*)a.norm_mix_g)[lane + 64 * j];
    for (int m = gw; m < M; m += NGW) {
        const f32x4* xr = (const f32x4*)(a.x + (size_t)m * D) + lane;
        f32x4 v[4]; float s = 0.f;
#pragma unroll
        for (int j = 0; j < 4; ++j) { v[j] = xr[64 * j]; s += (v[j].x * v[j].x + v[j].y * v[j].y) + (v[j].z * v[j].z + v[j].w * v[j].w); }
        const float rstd = rsqrtf(wave_sum(s) * (1.0f / D) + EPS);
        u32x2* o8 = (u32x2*)(XN + (size_t)m * D) + lane;
#pragma unroll
        for (int j = 0; j < 4; ++j) { const f32x4 t = v[j] * rstd * gm[j]; u32x2 w; w.x = pk2(t.x, t.y); w.y = pk2(t.z, t.w); o8[64 * j] = w; }
    }
}

constexpr int NAT_P = 272, TR_P = 80;
constexpr int L_QH = 0, L_KH = 8704, L_QI = 17408, L_KOT = 26112, L_VT = 36352, L_DEC = 46592, L_TS = 47104, L_SSQ = 49152;
#define MFMA32(a, b, c) __builtin_amdgcn_mfma_f32_32x32x16_bf16((a), (b), (c), 0, 0, 0)
__device__ __forceinline__ bf16x8 pack8(const f32x16& x, int s) {
    u32x4 p; p.x = pk2(x[8 * s + 0], x[8 * s + 1]); p.y = pk2(x[8 * s + 2], x[8 * s + 3]); p.z = pk2(x[8 * s + 4], x[8 * s + 5]); p.w = pk2(x[8 * s + 6], x[8 * s + 7]);
    return __builtin_bit_cast(bf16x8, p);
}
__device__ __forceinline__ bf16x8 cat4(s16x4 lo, s16x4 hi) { bf16x8 r; r[0] = lo[0]; r[1] = lo[1]; r[2] = lo[2]; r[3] = lo[3]; r[4] = hi[0]; r[5] = hi[1]; r[6] = hi[2]; r[7] = hi[3]; return r; }

template <bool FULL>
__device__ __forceinline__ void scan_item(const Args& a, LAS unsigned char* lds, int item, int tid, int wave, int lane) {
    unsigned char* ws = a.ws;
    const int bh = item >> 4, sc = item & 15, b = bh >> 2, h = bh & 3;
    const int row0 = b * SEQ + sc * 256;
    const int d = tid & 127, tg = tid >> 7;
    const int hf = lane >> 5, l32 = lane & 31, c = wave;
    const float* Gp = (const float*)(ws + WS_G) + (size_t)row0 * HW + h * HD + d;
    const bf16* Qp = (const bf16*)(ws + WS_Q) + (size_t)row0 * HW + h * HD + d;
    const bf16* Vp = (const bf16*)(ws + WS_V) + (size_t)row0 * HW + h * HD + d;
    float* SLOC = (float*)(ws + WS_SLOC); float* DSC = (float*)(ws + WS_DSC);
    f32x16 S[4];
#pragma unroll
    for (int a4 = 0; a4 < 4; ++a4)
#pragma unroll
        for (int r = 0; r < 16; ++r) S[a4][r] = 0.f;
    if (FULL && wave < 4) {
        for (int j = 0; j < sc; ++j) {
            const float* sl = SLOC + ((size_t)(bh * 16 + j) * 4 + c) * 4096 + lane; const float* dj = DSC + (size_t)(bh * 16 + j) * HD;
#pragma unroll
            for (int a4 = 0; a4 < 4; ++a4)
#pragma unroll
                for (int rq = 0; rq < 4; ++rq) { const f32x4 dv = *(const f32x4*)(dj + 32 * a4 + 8 * rq + 4 * hf);
#pragma unroll
                    for (int e = 0; e < 4; ++e) S[a4][4 * rq + e] = dv[e] * S[a4][4 * rq + e] + sl[(a4 * 16 + 4 * rq + e) * 64]; }
        }
    }
    float gl[8], ql[8], vl[8];
#pragma unroll
    for (int s = 0; s < 8; ++s) { const size_t o = (size_t)(8 * tg + s) * HW; gl[s] = Gp[o]; vl[s] = bflo((unsigned)Vp[o]); ql[s] = FULL ? bflo((unsigned)Qp[o]) : 0.f; }
    float dtot = 0.f;
    for (int ch = 0; ch < 8; ++ch) {
        float g[8], q[8], v[8];
#pragma unroll
        for (int s = 0; s < 8; ++s) { g[s] = gl[s]; q[s] = ql[s]; v[s] = vl[s]; }
        if (ch < 7) {
#pragma unroll
            for (int s = 0; s < 8; ++s) { const size_t o = (size_t)((ch + 1) * 32 + 8 * tg + s) * HW; gl[s] = Gp[o]; vl[s] = bflo((unsigned)Vp[o]); ql[s] = FULL ? bflo((unsigned)Qp[o]) : 0.f; }
        }
        float p[8]; p[0] = g[0];
#pragma unroll
        for (int s = 1; s < 8; ++s) p[s] = p[s - 1] + g[s];
        LAS float* TS = (LAS float*)(lds + L_TS);
        TS[tg * 128 + d] = p[7];
        __syncthreads();
        const float t0 = TS[d], t1 = TS[128 + d], t2 = TS[256 + d], t3 = TS[384 + d];
        const float off = (tg > 0 ? t0 : 0.f) + (tg > 1 ? t1 : 0.f) + (tg > 2 ? t2 : 0.f);
        const float blast = (t0 + t1) + (t2 + t3), anchor = t0 + t1;
        float ko[8];
#pragma unroll
        for (int s = 0; s < 8; ++s) {
            const float bs = off + p[s], kk = 1.0f - __expf(g[s]);
            ko[s] = kk * __expf(blast - bs);
            if (FULL) {
                const int t = 8 * tg + s;
                *(LAS bf16*)(lds + L_QH + t * NAT_P + d * 2) = f2bf(q[s] * __expf(bs - anchor));
                *(LAS bf16*)(lds + L_KH + t * NAT_P + d * 2) = f2bf(kk * __expf(anchor - bs));
                *(LAS bf16*)(lds + L_QI + t * NAT_P + d * 2) = f2bf(q[s] * __expf(bs));
            }
        }
        { u32x4 w; w.x = pk2(ko[0], ko[1]); w.y = pk2(ko[2], ko[3]); w.z = pk2(ko[4], ko[5]); w.w = pk2(ko[6], ko[7]); *(LAS u32x4*)(lds + L_KOT + d * TR_P + tg * 16) = w; }
        { u32x4 w; w.x = pk2(v[0], v[1]); w.y = pk2(v[2], v[3]); w.z = pk2(v[4], v[5]); w.w = pk2(v[6], v[7]); *(LAS u32x4*)(lds + L_VT + d * TR_P + tg * 16) = w; }
        if (tg == 0) *(LAS float*)(lds + L_DEC + d * 4) = __expf(blast);
        dtot += blast;
        __syncthreads();
        f32x16 oT;
        if (wave < 4) {
            if (FULL) {
                f32x16 sT;
#pragma unroll
                for (int r = 0; r < 16; ++r) { sT[r] = 0.f; oT[r] = 0.f; }
#pragma unroll
                for (int ks = 0; ks < 8; ++ks) {
                    const bf16x8 ka = *(const LAS bf16x8*)(lds + L_KH + l32 * NAT_P + (16 * ks + 8 * hf) * 2);
                    const bf16x8 qb = *(const LAS bf16x8*)(lds + L_QH + l32 * NAT_P + (16 * ks + 8 * hf) * 2);
                    sT = MFMA32(ka, qb, sT);
                }
#pragma unroll
                for (int r = 0; r < 16; ++r) { const int j = (r & 3) + 8 * (r >> 2) + 4 * hf; if (j > l32) sT[r] = 0.f; }
#pragma unroll
                for (int ks = 0; ks < 2; ++ks) {
                    const s16x4 lo = *(const LAS s16x4*)(lds + L_VT + (32 * c + l32) * TR_P + (16 * ks + 4 * hf) * 2);
                    const s16x4 hi = *(const LAS s16x4*)(lds + L_VT + (32 * c + l32) * TR_P + (16 * ks + 8 + 4 * hf) * 2);
                    oT = MFMA32(cat4(lo, hi), pack8(sT, ks), oT);
                }
#pragma unroll
                for (int a4 = 0; a4 < 4; ++a4)
#pragma unroll
                    for (int ks = 0; ks < 2; ++ks) {
                        const s16x4 lo = *(const LAS s16x4*)(lds + L_QI + l32 * NAT_P + (32 * a4 + 16 * ks + 4 * hf) * 2);
                        const s16x4 hi = *(const LAS s16x4*)(lds + L_QI + l32 * NAT_P + (32 * a4 + 16 * ks + 8 + 4 * hf) * 2);
                        oT = MFMA32(pack8(S[a4], ks), cat4(lo, hi), oT);
                    }
            }
#pragma unroll
            for (int a4 = 0; a4 < 4; ++a4) {
#pragma unroll
                for (int rq = 0; rq < 4; ++rq) { const f32x4 dv = *(const LAS f32x4*)(lds + L_DEC + (32 * a4 + 8 * rq + 4 * hf) * 4);
#pragma unroll
                    for (int e = 0; e < 4; ++e) S[a4][4 * rq + e] *= dv[e]; }
#pragma unroll
                for (int ks = 0; ks < 2; ++ks) {
                    const bf16x8 ka = *(const LAS bf16x8*)(lds + L_KOT + (32 * a4 + l32) * TR_P + (16 * ks + 8 * hf) * 2);
                    const bf16x8 vb = *(const LAS bf16x8*)(lds + L_VT + (32 * c + l32) * TR_P + (16 * ks + 8 * hf) * 2);
                    S[a4] = MFMA32(ka, vb, S[a4]);
                }
            }
            if (FULL) {
                float ssq = 0.f;
#pragma unroll
                for (int r = 0; r < 16; ++r) ssq += oT[r] * oT[r];
                ssq += __shfl_xor(ssq, 32);
                if (lane < 32) *(LAS float*)(lds + L_SSQ + (c * 32 + l32) * 4) = ssq;
            }
        }
        if (FULL) {
            __syncthreads();
            if (wave < 4) {
                const LAS float* SQ = (const LAS float*)(lds + L_SSQ);
                const float tot = (SQ[l32] + SQ[32 + l32]) + (SQ[64 + l32] + SQ[96 + l32]);
                const float rstd = rsqrtf(tot * (1.0f / HD) + EPS);
                const size_t ro = (size_t)(row0 + ch * 32 + l32) * HW + h * HD;
#pragma unroll
                for (int rq = 0; rq < 4; ++rq) { const int dv0 = 32 * c + 8 * rq + 4 * hf;
                    const u32x2 gs = *(const u32x2*)((const bf16*)(ws + WS_GS) + ro + dv0); const f32x4 ng = *(const f32x4*)(a.hg_norm_g + dv0);
                    const float o0 = oT[4 * rq + 0] * rstd * ng[0] * bflo(gs.x), o1 = oT[4 * rq + 1] * rstd * ng[1] * bfhi(gs.x);
                    const float o2 = oT[4 * rq + 2] * rstd * ng[2] * bflo(gs.y), o3 = oT[4 * rq + 3] * rstd * ng[3] * bfhi(gs.y);
                    u32x2 w; w.x = pk2(o0, o1); w.y = pk2(o2, o3);
                    *(u32x2*)((bf16*)(ws + WS_HG) + ro + dv0) = w; }
            }
        }
    }
    if (!FULL) {
        if (wave < 4) { float* sl = SLOC + ((size_t)item * 4 + c) * 4096 + lane;
#pragma unroll
            for (int a4 = 0; a4 < 4; ++a4)
#pragma unroll
                for (int r = 0; r < 16; ++r) sl[(a4 * 16 + r) * 64] = S[a4][r]; }
        if (tg == 0) DSC[(size_t)item * HD + d] = __expf(dtot);
    }
    __syncthreads();
}
__device__ __forceinline__ void conv_items(const Args& a, int tid, int G) {
    unsigned char* ws = a.ws;
    const bf16* CG = (const bf16*)(ws + WS_CG); const bf16* XB = (const bf16*)(ws + WS_XB); bf16* BG = (bf16*)(ws + WS_BG);
    for (int it = blockIdx.x * NTHR + tid; it < (M / 8) * (HW / 8); it += G * NTHR) {
        const int tgp = it >> 6, c0 = (it & 63) * 8, t0 = tgp * 8;
        float w0[8], w1[8], w2[8], um2[8], um1[8];
#pragma unroll
        for (int e = 0; e < 8; ++e) { w0[e] = a.conv_w[c0 + e]; w1[e] = a.conv_w[HW + c0 + e]; w2[e] = a.conv_w[2 * HW + c0 + e]; um2[e] = 0.f; um1[e] = 0.f; }
        if ((t0 & (SEQ - 1)) != 0) {
            const u32x4 ca = *(const u32x4*)(CG + (size_t)(t0 - 2) * HW + c0), xa = *(const u32x4*)(XB + (size_t)(t0 - 2) * HW + c0);
            const u32x4 cb = *(const u32x4*)(CG + (size_t)(t0 - 1) * HW + c0), xb = *(const u32x4*)(XB + (size_t)(t0 - 1) * HW + c0);
#pragma unroll
            for (int e = 0; e < 4; ++e) { um2[2 * e] = bflo(ca[e]) * bflo(xa[e]); um2[2 * e + 1] = bfhi(ca[e]) * bfhi(xa[e]); um1[2 * e] = bflo(cb[e]) * bflo(xb[e]); um1[2 * e + 1] = bfhi(cb[e]) * bfhi(xb[e]); }
        }
#pragma unroll
        for (int s = 0; s < 8; ++s) {
            const size_t ro = (size_t)(t0 + s) * HW + c0;
            const u32x4 cc = *(const u32x4*)(CG + ro), xx = *(const u32x4*)(XB + ro), bb = *(const u32x4*)(BG + ro);
            float u[8], o[8];
#pragma unroll
            for (int e = 0; e < 4; ++e) { u[2 * e] = bflo(cc[e]) * bflo(xx[e]); u[2 * e + 1] = bfhi(cc[e]) * bfhi(xx[e]); }
#pragma unroll
            for (int e = 0; e < 8; ++e) { const float y = w0[e] * um2[e] + w1[e] * um1[e] + w2[e] * u[e]; o[e] = y * ((e & 1) ? bfhi(bb[e >> 1]) : bflo(bb[e >> 1])); um2[e] = um1[e]; um1[e] = u[e]; }
            u32x4 w; w.x = pk2(o[0], o[1]); w.y = pk2(o[2], o[3]); w.z = pk2(o[4], o[5]); w.w = pk2(o[6], o[7]);
            *(u32x4*)(BG + ro) = w;
        }
    }
}
__device__ __forceinline__ void final_norm(const Args& a, int wave, int lane, int G) {
    const float* ss = (const float*)(a.ws + WS_SS2);
    f32x4 gm[4];
#pragma unroll
    for (int j = 0; j < 4; ++j) gm[j] = ((const f32x4*)a.norm_final_g)[lane + 64 * j];
    for (int m = blockIdx.x * NWAVES + wave; m < M; m += G * NWAVES) {
        const f32x4* sp = (const f32x4*)(ss + (size_t)m * 16); const f32x4 s4 = (sp[0] + sp[1]) + (sp[2] + sp[3]);
        const float rstd = rsqrtf(((s4[0] + s4[1]) + (s4[2] + s4[3])) * (1.0f / D) + EPS);
        f32x4* xr = (f32x4*)(a.out + (size_t)m * D) + lane;
#pragma unroll
        for (int j = 0; j < 4; ++j) xr[64 * j] = xr[64 * j] * rstd * gm[j];
    }
}

__global__ void __launch_bounds__(NTHR, 2) hybrid_fwd(Args a) {
    extern __shared__ __attribute__((aligned(16))) unsigned char lds_raw[];
    LAS unsigned char* lds = (LAS unsigned char*)lds_raw;
    cg::grid_group grid = cg::this_grid();
    const int tid = threadIdx.x, lane = tid & 63, wave = __builtin_amdgcn_readfirstlane(tid >> 6), G = gridDim.x;
    unsigned char* ws = a.ws;
    p0_prologue(a, lds, wave, lane, G);
    grid.sync();
    { pg8::Gemm g{(const bf16*)a.out, (const bf16*)(ws + WS_WIN), nullptr, nullptr, M, NIN, D}; pg8::StaticOrder S; S.init(M, NIN, G, (int)blockIdx.x);
      EpiProj E{ws, a.lower_bounds};
      pg8::gemm_phase<EpiProj, pg8::StaticOrder, PG8_ALIGN, PG8_SP2>(lds, g, S, E); }
    grid.sync();
    for (int item = blockIdx.x; item < 256; item += G) scan_item<false>(a, lds, item, tid, wave, lane);
    conv_items(a, tid, G);
    grid.sync();
    for (int item = blockIdx.x; item < 256; item += G) scan_item<true>(a, lds, item, tid, wave, lane);
    grid.sync();
    { pg8::Gemm g{(const bf16*)(ws + WS_HG), (const bf16*)(ws + WS_WA), (const bf16*)(ws + WS_CV), (const bf16*)(ws + WS_WB), M, D, HW}; pg8::StaticOrder S; S.init(M, D, G, (int)blockIdx.x, 1);
      EpiBranch E{(const bf16*)(ws + WS_GA), (const bf16*)(ws + WS_GB), (bf16*)(ws + WS_MG)};
      pg8::gemm_phase<EpiBranch, pg8::StaticOrder, PG8_ALIGN, PG8_SP2>(lds, g, S, E); }
    grid.sync();
    { pg8::Gemm g{(const bf16*)(ws + WS_MG), (const bf16*)(ws + WS_WO), nullptr, nullptr, M, D, D}; pg8::StaticOrder S; S.init(M, D, G, (int)blockIdx.x);
      EpiRes<true> E{a.x, a.out, (bf16*)(ws + WS_XN2), a.norm_ffn_g, (float*)(ws + WS_SS1)};
      pg8::gemm_phase<EpiRes<true>, pg8::StaticOrder, PG8_ALIGN, PG8_SP2>(lds, g, S, E); }
    grid.sync();
    { pg8::Gemm g{(const bf16*)(ws + WS_XN2), (const bf16*)(ws + WS_WGU), nullptr, nullptr, M, 2 * FF, D}; pg8::StaticOrder S; S.init(M, 2 * FF, G, (int)blockIdx.x);
      EpiGU E{(const float*)(ws + WS_SS1), (bf16*)(ws + WS_H)};
      pg8::gemm_phase<EpiGU, pg8::StaticOrder, PG8_ALIGN, PG8_SP2>(lds, g, S, E); }
    grid.sync();
    { pg8::Gemm g{(const bf16*)(ws + WS_H), (const bf16*)(ws + WS_WD), nullptr, nullptr, M, D, FF}; pg8::StaticOrder S; S.init(M, D, G, (int)blockIdx.x);
      EpiRes<false> E{a.out, a.out, nullptr, nullptr, (float*)(ws + WS_SS2)};
      pg8::gemm_phase<EpiRes<false>, pg8::StaticOrder, PG8_ALIGN, PG8_SP2>(lds, g, S, E); }
    grid.sync();
    final_norm(a, wave, lane, G);
}

extern "C" void kernel_launch(void* const* d_in, const int* in_sizes, int n_in, void* d_out, int out_size, void* d_ws, size_t ws_size, hipStream_t stream) {
    static int grid = 0;
    if (grid == 0) {
        if (n_in != 14 || out_size != M * D || ws_size < WS_END) { fprintf(stderr, "kernel_launch: unexpected shapes (n_in %d out %d ws %zu)\n", n_in, out_size, ws_size); grid = -1; return; }
        int dev = 0, cus = 0, per_cu = 0;
        (void)hipGetDevice(&dev);
        (void)hipDeviceGetAttribute(&cus, hipDeviceAttributeMultiprocessorCount, dev);
        (void)hipFuncSetAttribute((const void*)hybrid_fwd, hipFuncAttributeMaxDynamicSharedMemorySize, LDS_BYTES);
        (void)hipOccupancyMaxActiveBlocksPerMultiprocessor(&per_cu, (const void*)hybrid_fwd, NTHR, LDS_BYTES);
        if (per_cu < 1) { fprintf(stderr, "kernel_launch: occupancy query reports %d blocks per CU\n", per_cu); grid = -1; return; }
        grid = cus;
    }
    if (grid < 0) return;
    Args a{};
    a.x = (const float*)d_in[0]; a.norm_mix_g = (const float*)d_in[1]; a.w_in = (const float*)d_in[2]; a.lower_bounds = (const float*)d_in[3]; a.hg_norm_g = (const float*)d_in[4];
    a.conv_w = (const float*)d_in[5]; a.w_branch_a = (const float*)d_in[6]; a.w_branch_b = (const float*)d_in[7]; a.w_out = (const float*)d_in[8]; a.norm_ffn_g = (const float*)d_in[9];
    a.w_ffn_gate = (const float*)d_in[10]; a.w_ffn_up = (const float*)d_in[11]; a.w_ffn_down = (const float*)d_in[12]; a.norm_final_g = (const float*)d_in[13];
    a.out = (float*)d_out; a.ws = (unsigned char*)d_ws;
    void* args[] = {&a};
    hipError_t e = hipLaunchCooperativeKernel((const void*)hybrid_fwd, dim3(grid), dim3(NTHR), args, LDS_BYTES, stream);
    if (e != hipSuccess) fprintf(stderr, "kernel_launch: cooperative launch failed: %s (grid %d)\n", hipGetErrorString(e), grid);
}
```

```cpp
#include <hip/hip_runtime.h>
#include <hip/hip_cooperative_groups.h>
#include <cstdio>
#include <cstdint>
namespace cg = cooperative_groups;
namespace pg8 {
#define PG8_LAS __attribute__((address_space(3)))
typedef unsigned short bf16_t;
typedef short bf16x8 __attribute__((ext_vector_type(8)));
typedef float f32x4 __attribute__((ext_vector_type(4)));
typedef unsigned u32x4 __attribute__((ext_vector_type(4)));
constexpr int BM = 256, BK = 64, HALF = 128, HTB = HALF * BK * 2  , STAGE_BYTES = 8 * HTB, NXCD = 8, WGM = 8;

__host__ __device__ __forceinline__ int lds_byte(int r, int c) { const int st = (r >> 4) * 2 + (c >> 5), rr = r & 15, cc = c & 31, ob = rr * 64 + cc * 2; return st * 1024 + (ob ^ (((ob >> 9) & 1) << 5)); }
__host__ __device__ __forceinline__ void stage_rc(int b, int& R, int& C) { const int st = b / 1024, sb = b % 1024, swz = sb ^ (((sb >> 9) & 1) << 5); R = (st >> 1) * 16 + swz / 64; C = (st & 1) * 32 + (swz % 64) / 2; }
__host__ __device__ __forceinline__ int perm32(int rho) { const int n = rho >> 4, i = rho & 15; return 8 * (i >> 2) + 4 * n + (i & 3); }

struct Unit { int pm, pn, sel; };
struct Gemm { const bf16_t* A; const bf16_t* Bt; const bf16_t* A2; const bf16_t* Bt2; int M, N, K; };

struct StaticOrder {
    int nM, nN, nwg, G, c, dual;
    __host__ __device__ void init(int M, int N, int G_, int c_, int dual_ = 0) { nM = M / BM; nN = N / BM; nwg = nM * nN; G = G_; c = c_; dual = dual_; }
    __host__ __device__ bool next(int i_, Unit& u) const {
        const int i = dual ? (i_ >> 1) : i_; u.sel = dual ? (i_ & 1) : 0;
        const long L = (long)i * G + c; if (L >= nwg) return false;
        int wgid = (int)L; { const int q = nwg / NXCD, r = nwg % NXCD, xcd = wgid % NXCD, off = wgid / NXCD; wgid = (xcd < r ? xcd * (q + 1) : r * (q + 1) + (xcd - r) * q) + off; }
        const int nig = WGM * nN, gid = wgid / nig, fm = gid * WGM, gsz = (nM - fm) < WGM ? (nM - fm) : WGM;
        u.pm = fm + ((wgid % nig) % gsz); u.pn = (wgid % nig) / gsz; return true;
    }
    __device__ __forceinline__ void a_ready(const Unit&) const {}
    __device__ __forceinline__ void done(const Unit&) const {}
};

__device__ __forceinline__ unsigned cvt_pk_bf16(float lo, float hi) { unsigned r; asm volatile("v_cvt_pk_bf16_f32 %0, %1, %2" : "=v"(r) : "v"(lo), "v"(hi)); return r; }
template <class Epi, class Sched, bool ALIGN_EPI = false, bool SP2 = false>
__device__ __forceinline__ void gemm_phase(PG8_LAS unsigned char* lds, const Gemm g, const Sched& S, const Epi& E) {
    const int tid = threadIdx.x, wid = __builtin_amdgcn_readfirstlane(tid >> 6), lane = tid & 63, wr = wid >> 2, wc = wid & 3, fr = lane & 15, fq = lane >> 4;
    const int K = g.K, nt = K / BK;
    unsigned voffA[2], voffB[2];
#pragma unroll
    for (int i = 0; i < 2; ++i) { int R, C; stage_rc(tid * 16 + i * 8192, R, C); const int Rb = Epi::PERM ? ((R & ~31) + perm32(R & 31)) : R;
        voffA[i] = (unsigned)(R * K + C) * 2u; voffB[i] = (unsigned)(Rb * K + C) * 2u; }
    const size_t kstep = (size_t)(BK * 2);
    const size_t hstep = (size_t)HALF * K * 2;
    const size_t tstep = 2 * hstep;
    const unsigned ldsw = (unsigned)wid * 1024u;
    const int aoff = lds_byte(wr * 64 + fr, fq * 8), boff = lds_byte(wc * 32 + fr, fq * 8);
#define PG8_SA(b, h) (((b) * 2 + (h)) * HTB)
#define PG8_SB(b, h) ((4 + (b) * 2 + (h)) * HTB)
#define PG8_STAGE(bufoff, gbase, voff) do { _Pragma("unroll") for (int _i = 0; _i < 2; ++_i) \
        __builtin_amdgcn_global_load_lds((const unsigned*)((const char*)(gbase) + (voff)[_i]), (PG8_LAS unsigned*)(lds + (bufoff) + ldsw + _i * 8192), 16, 0, 0); } while (0)
#define PG8_LDA(dst, b, h) do { _Pragma("unroll") for (int m = 0; m < 4; ++m) _Pragma("unroll") for (int k = 0; k < 2; ++k) dst[m][k] = *(const PG8_LAS bf16x8*)(lds + PG8_SA(b, h) + aoff + m * 2048 + k * 1024); } while (0)
#define PG8_LDB(dst, b, h) do { _Pragma("unroll") for (int n = 0; n < 2; ++n) _Pragma("unroll") for (int k = 0; k < 2; ++k) dst[n][k] = *(const PG8_LAS bf16x8*)(lds + PG8_SB(b, h) + boff + n * 2048 + k * 1024); } while (0)
#define PG8_MMA(ai, bj, At, Bt) do { __builtin_amdgcn_s_setprio(1); _Pragma("unroll") for (int m = 0; m < 4; ++m) _Pragma("unroll") for (int n = 0; n < 2; ++n) _Pragma("unroll") for (int k = 0; k < 2; ++k) \
        acc[ai][bj][m][n] = __builtin_amdgcn_mfma_f32_16x16x32_bf16(Bt[n][k], At[m][k], acc[ai][bj][m][n], 0, 0, 0); __builtin_amdgcn_s_setprio(0); } while (0)
#define PG8_WAIT_V(n) asm volatile("s_waitcnt vmcnt(" #n ")" ::: "memory")
#define PG8_WAIT_L(n) asm volatile("s_waitcnt lgkmcnt(" #n ")" ::: "memory")
#define PG8_BAR __builtin_amdgcn_s_barrier()
#define PG8_SCHED __builtin_amdgcn_sched_barrier(0)
    Unit cur, nxt; int ui = 0;
    if (!S.next(0, cur)) return;
    f32x4 acc[2][2][4][2];
#pragma unroll
    for (int a = 0; a < 2; ++a)
#pragma unroll
        for (int b = 0; b < 2; ++b)
#pragma unroll
            for (int m = 0; m < 4; ++m)
#pragma unroll
                for (int n = 0; n < 2; ++n) acc[a][b][m][n] = (f32x4){0.f, 0.f, 0.f, 0.f};
    bf16x8 At[4][2], B0[2][2], B1[2][2];
    const char* cA = (const char*)(cur.sel ? g.A2 : g.A) + (size_t)cur.pm * tstep; const char* cB = (const char*)(cur.sel ? g.Bt2 : g.Bt) + (size_t)cur.pn * tstep;
    S.a_ready(cur);
    if constexpr (SP2) {
        PG8_STAGE(PG8_SB(0, 0), cB, voffB); PG8_STAGE(PG8_SB(0, 1), cB + hstep, voffB); PG8_STAGE(PG8_SA(0, 0), cA, voffA); PG8_STAGE(PG8_SA(0, 1), cA + hstep, voffA);
        if (wr == 1) PG8_BAR;
        PG8_WAIT_V(2); PG8_BAR;
        PG8_STAGE(PG8_SB(1, 0), cB + kstep, voffB); PG8_STAGE(PG8_SA(1, 0), cA + kstep, voffA); PG8_STAGE(PG8_SB(1, 1), cB + hstep + kstep, voffB);
        PG8_WAIT_V(6); PG8_BAR;
    } else {
        PG8_STAGE(PG8_SB(0, 0), cB, voffB); PG8_STAGE(PG8_SA(0, 0), cA, voffA); PG8_STAGE(PG8_SB(0, 1), cB + hstep, voffB); PG8_STAGE(PG8_SA(0, 1), cA + hstep, voffA);
        if (wr == 1) PG8_BAR;
        PG8_WAIT_V(4); PG8_BAR;
        PG8_STAGE(PG8_SB(1, 0), cB + kstep, voffB); PG8_STAGE(PG8_SA(1, 0), cA + kstep, voffA); PG8_STAGE(PG8_SB(1, 1), cB + hstep + kstep, voffB);
        PG8_WAIT_V(6); PG8_BAR;
    }
    for (;;) {
        const bool has_next = S.next(ui + 1, nxt);
        const char* nA = has_next ? (const char*)(nxt.sel ? g.A2 : g.A) + (size_t)nxt.pm * tstep : cA; const char* nB = has_next ? (const char*)(nxt.sel ? g.Bt2 : g.Bt) + (size_t)nxt.pn * tstep : cB;
        for (int t = 0; t < nt; t += 2) {
            const bool last = (t == nt - 2);
            const char* a1 = cA + (size_t)(t + 1) * kstep;
            const char* a2 = last ? nA : cA + (size_t)(t + 2) * kstep; const char* b2 = last ? nB : cB + (size_t)(t + 2) * kstep;
            const char* a3 = a2 + kstep; const char* b3 = b2 + kstep;
            if (last && has_next) S.a_ready(nxt);
            if constexpr (SP2) {
            PG8_LDB(B0, 0, 0); PG8_LDB(B1, 0, 1); PG8_SCHED; PG8_LDA(At, 0, 0); PG8_STAGE(PG8_SA(1, 1), a1 + hstep, voffA);
            PG8_WAIT_V(8); PG8_WAIT_L(0); PG8_BAR; PG8_MMA(0, 0, At, B0); PG8_MMA(0, 1, At, B1); PG8_BAR; PG8_SCHED;
            PG8_LDA(At, 0, 1); PG8_STAGE(PG8_SB(0, 0), b2, voffB); PG8_STAGE(PG8_SB(0, 1), b2 + hstep, voffB); PG8_STAGE(PG8_SA(0, 0), a2, voffA);
            PG8_WAIT_V(8); PG8_WAIT_L(0); PG8_BAR; PG8_MMA(1, 0, At, B0); PG8_MMA(1, 1, At, B1); PG8_BAR; PG8_SCHED;
            PG8_LDB(B0, 1, 0); PG8_LDB(B1, 1, 1); PG8_SCHED; PG8_LDA(At, 1, 0); PG8_STAGE(PG8_SA(0, 1), a2 + hstep, voffA);
            PG8_WAIT_V(8); PG8_WAIT_L(0); PG8_BAR; PG8_MMA(0, 0, At, B0); PG8_MMA(0, 1, At, B1); PG8_BAR; PG8_SCHED;
            PG8_LDA(At, 1, 1); PG8_STAGE(PG8_SB(1, 0), b3, voffB); PG8_STAGE(PG8_SB(1, 1), b3 + hstep, voffB); PG8_STAGE(PG8_SA(1, 0), a3, voffA);
            PG8_WAIT_V(8); PG8_WAIT_L(0); PG8_BAR; PG8_MMA(1, 0, At, B0); PG8_MMA(1, 1, At, B1); PG8_BAR; PG8_SCHED;
            } else {
            PG8_LDB(B0, 0, 0); PG8_SCHED; PG8_LDA(At, 0, 0); PG8_STAGE(PG8_SA(1, 1), a1 + hstep, voffA);
            PG8_WAIT_L(8); PG8_BAR; PG8_WAIT_L(0); PG8_MMA(0, 0, At, B0); PG8_BAR; PG8_SCHED;
            PG8_LDB(B1, 0, 1); PG8_STAGE(PG8_SB(0, 0), b2, voffB);
            PG8_BAR; PG8_WAIT_L(0); PG8_MMA(0, 1, At, B1); PG8_BAR;
            PG8_LDA(At, 0, 1); PG8_STAGE(PG8_SA(0, 0), a2, voffA);
            PG8_BAR; PG8_WAIT_L(0); PG8_MMA(1, 0, At, B0); PG8_BAR; PG8_SCHED;
            PG8_STAGE(PG8_SB(0, 1), b2 + hstep, voffB);
            PG8_WAIT_V(6); PG8_BAR; PG8_MMA(1, 1, At, B1); PG8_BAR;
            PG8_LDB(B0, 1, 0); PG8_SCHED; PG8_LDA(At, 1, 0); PG8_STAGE(PG8_SA(0, 1), a2 + hstep, voffA);
            PG8_WAIT_L(8); PG8_BAR; PG8_WAIT_L(0); PG8_MMA(0, 0, At, B0); PG8_BAR; PG8_SCHED;
            PG8_LDB(B1, 1, 1); PG8_STAGE(PG8_SB(1, 0), b3, voffB);
            PG8_BAR; PG8_WAIT_L(0); PG8_MMA(0, 1, At, B1); PG8_BAR;
            PG8_LDA(At, 1, 1); PG8_STAGE(PG8_SA(1, 0), a3, voffA);
            PG8_BAR; PG8_WAIT_L(0); PG8_MMA(1, 0, At, B0); PG8_BAR; PG8_SCHED;
            PG8_STAGE(PG8_SB(1, 1), b3 + hstep, voffB);
            PG8_WAIT_V(6); PG8_BAR; PG8_MMA(1, 1, At, B1); PG8_BAR;
            }
        }
        if constexpr (ALIGN_EPI) { if (wr == 0) PG8_BAR; }
        bool keep = false; if constexpr (!Epi::AFTER_DRAIN) { keep = E(acc, cur, wr, wc, fr, fq); S.done(cur); }
        if (!has_next) break;
        if (!keep) {
#pragma unroll
        for (int a = 0; a < 2; ++a)
#pragma unroll
            for (int b = 0; b < 2; ++b)
#pragma unroll
                for (int m = 0; m < 4; ++m)
#pragma unroll
                    for (int n = 0; n < 2; ++n) acc[a][b][m][n] = (f32x4){0.f, 0.f, 0.f, 0.f};
        }
        cur = nxt; cA = nA; cB = nB; ++ui;
        if constexpr (ALIGN_EPI) { if (wr == 1) PG8_BAR; }
    }
    PG8_WAIT_V(0);
    if constexpr (!ALIGN_EPI) { if (wr == 0) PG8_BAR; }
    PG8_BAR;
    if constexpr (Epi::AFTER_DRAIN) { E.fused(acc, cur, wr, wc, fr, fq, lds, wid, lane); S.done(cur); }
#undef PG8_SA
#undef PG8_SB
#undef PG8_STAGE
#undef PG8_LDA
#undef PG8_LDB
#undef PG8_MMA
#undef PG8_WAIT_V
#undef PG8_WAIT_L
#undef PG8_BAR
#undef PG8_SCHED
}
}

#define PG8_SP2 true
#define PG8_ALIGN true

constexpr int NWAVES = 8, NTHR = 512;
constexpr int BATCH = 4, SEQ = 4096, D = 1024, M = BATCH * SEQ, HW = 512, HD = 128, NH = 4, NIN = 5632, FF = 2816;
constexpr float EPS = 1e-6f;
constexpr int LDS_BYTES = 147456;
constexpr size_t MiB = 1u << 20;
constexpr size_t WS_SS1 = 0, WS_SS2 = 1 * MiB, WS_DSC = 2 * MiB, WS_BAR = 3 * MiB;
constexpr int LDS_ST_OFF = 131072 + 320;
constexpr size_t WS_WIN = 4 * MiB, WS_WGU = 15 * MiB, WS_WD = 26 * MiB, WS_WO = 32 * MiB, WS_WA = 34 * MiB, WS_WB = 35 * MiB;
constexpr size_t WS_Q = 36 * MiB, WS_V = 52 * MiB, WS_GS = 68 * MiB, WS_G = 84 * MiB, WS_CG = 116 * MiB, WS_BG = 132 * MiB, WS_XB = 148 * MiB, WS_GA = 164 * MiB, WS_GB = 196 * MiB, WS_SLOC = 228 * MiB;
constexpr size_t WS_CV = WS_BG, WS_HG = WS_CG, WS_MG = WS_Q, WS_XN2 = WS_G, WS_H = WS_CG, WS_END = 244 * MiB;

#define LAS __attribute__((address_space(3)))
typedef unsigned short bf16;
typedef float f32x4 __attribute__((ext_vector_type(4)));
typedef float f32x2 __attribute__((ext_vector_type(2)));
typedef float f32x16 __attribute__((ext_vector_type(16)));
typedef unsigned u32x4 __attribute__((ext_vector_type(4)));
typedef unsigned u32x2 __attribute__((ext_vector_type(2)));
typedef short bf16x8 __attribute__((ext_vector_type(8)));
typedef short s16x4 __attribute__((ext_vector_type(4)));
typedef __bf16 hbf2 __attribute__((ext_vector_type(2)));

__device__ __forceinline__ unsigned pk2(float lo, float hi) { f32x2 v = {lo, hi}; hbf2 b = __builtin_convertvector(v, hbf2); return __builtin_bit_cast(unsigned, b); }
__device__ __forceinline__ unsigned short f2bf(float f) { return (unsigned short)(pk2(f, 0.f) & 0xffffu); }
__device__ __forceinline__ float bflo(unsigned u) { return __uint_as_float(u << 16); }
__device__ __forceinline__ float bfhi(unsigned u) { return __uint_as_float(u & 0xffff0000u); }
__device__ __forceinline__ float sigm(float v) { return __fdividef(1.0f, 1.0f + __expf(-v)); }
__device__ __forceinline__ float silu(float v) { return __fdividef(v, 1.0f + __expf(-v)); }
__device__ __forceinline__ float wave_sum(float v) {
#pragma unroll
    for (int o = 1; o < 64; o <<= 1) v += __shfl_xor(v, o);
    return v;
}
#define LDS_WAIT() asm volatile("s_waitcnt lgkmcnt(0)" ::: "memory")
typedef __attribute__((address_space(1))) unsigned gu32;
#define VM_WAIT() asm volatile("s_waitcnt vmcnt(0)" ::: "memory")
#define XB_TMO      128
#define XB_XCNT(j)  (256  + 64 * (j))
#define XB_XSUB(j)  (1280 + 64 * (j))
#define XB_XGEN(j)  (2304 + 64 * (j))
#define XB_TOP      3328
#define XB_TOPGEN   3392
#define XCD_BAR_WORDS 3456
#define XB_SPIN_CAP (1u << 18)

__device__ __forceinline__ unsigned xb_ld(unsigned* p)              { return __hip_atomic_load(p, __ATOMIC_RELAXED, __HIP_MEMORY_SCOPE_AGENT); }
__device__ __forceinline__ unsigned xb_add(unsigned* p, unsigned v) { return __hip_atomic_fetch_add(p, v, __ATOMIC_RELAXED, __HIP_MEMORY_SCOPE_AGENT); }
__device__ __forceinline__ unsigned xb_xcc_id() { return (unsigned)__builtin_amdgcn_s_getreg((3 << 11) | 20) & 0xFu; }
#define XB_SPIN(cond, bar) do { unsigned _sp = 0; while (cond) { __builtin_amdgcn_s_sleep(1); \
    if ((++_sp & 255u) == 0u) { if (xb_ld(&(bar)[XB_TMO])) break; if (_sp > XB_SPIN_CAP) { atomicAdd(&(bar)[XB_TMO], 1u); break; } } } } while (0)

struct XcdBarrier {
    unsigned* bar; unsigned x;
    volatile LAS unsigned* st;
};

__device__ __forceinline__ XcdBarrier xcd_barrier_post(unsigned* bar, volatile LAS unsigned* st) {
    XcdBarrier b; b.bar = bar; b.x = xb_xcc_id(); b.st = st;
    if (threadIdx.x == 0) (void)xb_add(&bar[XB_XCNT(b.x)], 1u);
    return b;
}
__device__ __forceinline__ void xcd_barrier_complete(unsigned* bar, unsigned x, unsigned& nloc, unsigned& nx) {
    const unsigned G = gridDim.x * gridDim.y * gridDim.z;
    unsigned sum, cnt, mine, sp = 0u;
    for (;;) {
        sum = 0u; cnt = 0u; mine = 0u;
#pragma unroll
        for (unsigned j = 0; j < 16; ++j) { const unsigned c = xb_ld(&bar[XB_XCNT(j)]); sum += c; cnt += (c > 0u) ? 1u : 0u; mine = (j == x) ? c : mine; }
        if (sum == G) break;
        __builtin_amdgcn_s_sleep(1);
        if ((++sp & 255u) == 0u) { if (xb_ld(&bar[XB_TMO])) break; if (sp > XB_SPIN_CAP) { atomicAdd(&bar[XB_TMO], 1u); break; } }
    }
    nloc = mine > 0u ? mine : 1u; nx = cnt > 0u ? cnt : 1u;
}

__device__ __forceinline__ void xcd_barrier(const XcdBarrier& b) {
    asm volatile("s_waitcnt vmcnt(0)" ::: "memory");
    __syncthreads();
    if (threadIdx.x == 0) {
        unsigned* bar = b.bar;
        __builtin_amdgcn_s_waitcnt(0);
        unsigned nloc = b.st[0], nx = b.st[1];
        if (nloc == 0u) { xcd_barrier_complete(bar, b.x, nloc, nx); b.st[0] = nloc; b.st[1] = nx; }
        const unsigned old = xb_add(&bar[XB_XSUB(b.x)], 1u);
        const unsigned gen = old / nloc;
        if (old + 1u == (gen + 1u) * nloc) {
            __builtin_amdgcn_fence(__ATOMIC_RELEASE, "agent");
            asm volatile("s_waitcnt vmcnt(0)" ::: "memory");
            const unsigned og = xb_add(&bar[XB_TOP], 1u);
            const unsigned tg = og / nx;
            if (og + 1u == (tg + 1u) * nx) xb_add(&bar[XB_TOPGEN], 1u);
            else XB_SPIN(xb_ld(&bar[XB_TOPGEN]) == tg, bar);
            __builtin_amdgcn_fence(__ATOMIC_ACQUIRE, "agent");
            xb_add(&bar[XB_XGEN(b.x)], 1u);
            asm volatile("s_waitcnt vmcnt(0)" ::: "memory");
        } else {
            XB_SPIN(xb_ld(&bar[XB_XGEN(b.x)]) == gen, bar);
            __builtin_amdgcn_fence(__ATOMIC_ACQUIRE, "agent");
            asm volatile("s_waitcnt vmcnt(0)" ::: "memory");
        }
    }
    __syncthreads();
}


struct Args {
    const float *x, *norm_mix_g, *w_in, *lower_bounds, *hg_norm_g, *conv_w, *w_branch_a, *w_branch_b, *w_out, *norm_ffn_g, *w_ffn_gate, *w_ffn_up, *w_ffn_down, *norm_final_g;
    float* out; unsigned char* ws;
};

using pg8::Unit;
struct EpiProj {
    static constexpr bool PERM = true, AFTER_DRAIN = false;
    unsigned char* ws; const float* lbnd;
    __device__ __forceinline__ bool operator()(f32x4 (&acc)[2][2][4][2], const Unit& u, int wr, int wc, int fr, int fq) const {
        const int row0 = u.pm * 256 + wr * 64 + fr, pn = u.pn;
        int mode = 2, ldc = HW, colt; size_t off;
        if (pn < 2) { mode = 0; off = WS_Q; colt = pn * 256; }
        else if (pn < 4) { mode = 1; off = WS_G; colt = (pn - 2) * 256; }
        else if (pn < 6) { off = WS_V; colt = (pn - 4) * 256; }
        else if (pn < 8) { mode = 3; off = WS_GS; colt = (pn - 6) * 256; }
        else if (pn < 10) { off = WS_CG; colt = (pn - 8) * 256; }
        else if (pn < 12) { off = WS_BG; colt = (pn - 10) * 256; }
        else if (pn < 14) { off = WS_XB; colt = (pn - 12) * 256; }
        else if (pn < 18) { off = WS_GA; colt = (pn - 14) * 256; ldc = D; }
        else { off = WS_GB; colt = (pn - 18) * 256; ldc = D; }
        const int col0 = colt + wc * 32 + 8 * fq;
        if (mode == 1) {
            float* G = (float*)(ws + off);
            float lb[2][8];
#pragma unroll
            for (int bj = 0; bj < 2; ++bj)
#pragma unroll
                for (int j = 0; j < 8; ++j) { const int c = col0 + bj * 128 + j; lb[bj][j] = __fdividef(1.0f, 1.0f + __expf(lbnd[HW + c] - lbnd[c])); }
#pragma unroll
            for (int ai = 0; ai < 2; ++ai)
#pragma unroll
                for (int m = 0; m < 4; ++m) { float* rowp = G + (size_t)(row0 + ai * 128 + m * 16) * HW + col0;
#pragma unroll
                    for (int bj = 0; bj < 2; ++bj) {
#pragma unroll
                        for (int n = 0; n < 2; ++n) { f32x4 v = acc[ai][bj][m][n], o;
#pragma unroll
                            for (int e = 0; e < 4; ++e) { const float l = lb[bj][4 * n + e]; o[e] = logf(l + (1.0f - l) * sigm(v[e])); }
                            *(f32x4*)(rowp + bj * 128 + 4 * n) = o; } } }
        } else {
            bf16* O = (bf16*)(ws + off);
#pragma unroll
            for (int ai = 0; ai < 2; ++ai)
#pragma unroll
                for (int m = 0; m < 4; ++m) { bf16* rowp = O + (size_t)(row0 + ai * 128 + m * 16) * ldc + col0;
#pragma unroll
                    for (int bj = 0; bj < 2; ++bj) { f32x4 v0 = acc[ai][bj][m][0], v1 = acc[ai][bj][m][1];
                        if (mode == 0) {
#pragma unroll
                            for (int e = 0; e < 4; ++e) { v0[e] = silu(v0[e]) * 0.08838834764831845f; v1[e] = silu(v1[e]) * 0.08838834764831845f; }
                        } else if (mode == 3) {
#pragma unroll
                            for (int e = 0; e < 4; ++e) { v0[e] = silu(v0[e]); v1[e] = silu(v1[e]); }
                        }
                        u32x4 w; w.x = pk2(v0[0], v0[1]); w.y = pk2(v0[2], v0[3]); w.z = pk2(v1[0], v1[1]); w.w = pk2(v1[2], v1[3]);
                        *(u32x4*)(rowp + bj * 128) = w; } }
        }
        return false;
    }
};
struct EpiBranch {
    static constexpr bool PERM = true, AFTER_DRAIN = false;
    const bf16* GA; const bf16* GB; bf16* MG;
    __device__ __forceinline__ bool operator()(f32x4 (&acc)[2][2][4][2], const Unit& u, int wr, int wc, int fr, int fq) const {
        const int row0 = u.pm * 256 + wr * 64 + fr, col0 = u.pn * 256 + wc * 32 + 8 * fq;
        const bool first = (u.sel == 0);
#pragma unroll
        for (int ai = 0; ai < 2; ++ai)
#pragma unroll
            for (int m = 0; m < 4; ++m) { const size_t ro = (size_t)(row0 + ai * 128 + m * 16) * D + col0;
#pragma unroll
                for (int bj = 0; bj < 2; ++bj) {
                    const u32x4 gb = *(const u32x4*)(GB + ro + bj * 128);
                    float eb[8] = {bflo(gb.x), bfhi(gb.x), bflo(gb.y), bfhi(gb.y), bflo(gb.z), bfhi(gb.z), bflo(gb.w), bfhi(gb.w)};
#pragma unroll
                    for (int e = 0; e < 8; ++e) eb[e] = 1.0f + __expf(-eb[e]);
                    if (first) {
                        const u32x4 ga = *(const u32x4*)(GA + ro + bj * 128);
                        float ea[8] = {bflo(ga.x), bfhi(ga.x), bflo(ga.y), bfhi(ga.y), bflo(ga.z), bfhi(ga.z), bflo(ga.w), bfhi(ga.w)};
#pragma unroll
                        for (int e = 0; e < 8; ++e) { const float r = __fdividef(eb[e], 1.0f + __expf(-ea[e])); if (e < 4) acc[ai][bj][m][0][e] *= r; else acc[ai][bj][m][1][e - 4] *= r; }
                    } else {
                        float o[8];
#pragma unroll
                        for (int e = 0; e < 8; ++e) o[e] = __fdividef(e < 4 ? acc[ai][bj][m][0][e] : acc[ai][bj][m][1][e - 4], eb[e]);
                        u32x4 w; w.x = pk2(o[0], o[1]); w.y = pk2(o[2], o[3]); w.z = pk2(o[4], o[5]); w.w = pk2(o[6], o[7]);
                        *(u32x4*)(MG + ro + bj * 128) = w;
                    } } }
        return first;
    }
};
template <bool WITH_XN> struct EpiRes {
    static constexpr bool PERM = true, AFTER_DRAIN = false;
    const float* xi; float* xo; bf16* xn; const float* g; float* ss;
    __device__ __forceinline__ bool operator()(f32x4 (&acc)[2][2][4][2], const Unit& u, int wr, int wc, int fr, int fq) const {
        const int row0 = u.pm * 256 + wr * 64 + fr, col0 = u.pn * 256 + wc * 32 + 8 * fq;
        f32x4 gv[2][2];
        if (WITH_XN) {
#pragma unroll
            for (int bj = 0; bj < 2; ++bj)
#pragma unroll
                for (int n = 0; n < 2; ++n) gv[bj][n] = *(const f32x4*)(g + col0 + bj * 128 + 4 * n);
        }
#pragma unroll
        for (int ai = 0; ai < 2; ++ai)
#pragma unroll
            for (int m = 0; m < 4; ++m) { const int row = row0 + ai * 128 + m * 16; const size_t ro = (size_t)row * D + col0; float s = 0.f;
#pragma unroll
                for (int bj = 0; bj < 2; ++bj) {
                    const f32x4 v0 = acc[ai][bj][m][0] + *(const f32x4*)(xi + ro + bj * 128), v1 = acc[ai][bj][m][1] + *(const f32x4*)(xi + ro + bj * 128 + 4);
                    *(f32x4*)(xo + ro + bj * 128) = v0; *(f32x4*)(xo + ro + bj * 128 + 4) = v1;
                    s += (v0[0] * v0[0] + v0[1] * v0[1]) + (v0[2] * v0[2] + v0[3] * v0[3]) + (v1[0] * v1[0] + v1[1] * v1[1]) + (v1[2] * v1[2] + v1[3] * v1[3]);
                    if (WITH_XN) { const f32x4 a = v0 * gv[bj][0], b = v1 * gv[bj][1];
                        u32x4 w; w.x = pk2(a[0], a[1]); w.y = pk2(a[2], a[3]); w.z = pk2(b[0], b[1]); w.w = pk2(b[2], b[3]);
                        *(u32x4*)(xn + ro + bj * 128) = w; } }
                s += __shfl_xor(s, 16); s += __shfl_xor(s, 32);
                if (fq == 0) ss[(size_t)row * 16 + u.pn * 4 + wc] = s; }
        return false;
    }
};
struct EpiGU {
    static constexpr bool PERM = true, AFTER_DRAIN = false;
    const float* ss; bf16* H;
    __device__ __forceinline__ bool operator()(f32x4 (&acc)[2][2][4][2], const Unit& u, int wr, int wc, int fr, int fq) const {
        const int row0 = u.pm * 256 + wr * 64 + fr, col0 = u.pn * 128 + wc * 32 + 8 * fq;
#pragma unroll
        for (int ai = 0; ai < 2; ++ai)
#pragma unroll
            for (int m = 0; m < 4; ++m) { const int row = row0 + ai * 128 + m * 16;
                const f32x4* sp = (const f32x4*)(ss + (size_t)row * 16); const f32x4 s4 = (sp[0] + sp[1]) + (sp[2] + sp[3]);
                const float rstd = rsqrtf(((s4[0] + s4[1]) + (s4[2] + s4[3])) * (1.0f / D) + EPS);
                float o[8];
#pragma unroll
                for (int e = 0; e < 8; ++e) { const float gg = (e < 4 ? acc[ai][0][m][0][e] : acc[ai][0][m][1][e - 4]) * rstd, uu = (e < 4 ? acc[ai][1][m][0][e] : acc[ai][1][m][1][e - 4]) * rstd; o[e] = silu(gg) * uu; }
                u32x4 w; w.x = pk2(o[0], o[1]); w.y = pk2(o[2], o[3]); w.z = pk2(o[4], o[5]); w.w = pk2(o[6], o[7]);
                *(u32x4*)(H + (size_t)row * FF + col0) = w; }
        return false;
    }
};

__device__ __forceinline__ void transpose_item(const float* W, int K, int N, bf16* WT, int k0, int n0, int drow0, LAS float* scr, int lane) {
#pragma unroll 8
    for (int i = 0; i < 32; ++i) { const int kk = 2 * i + (lane >> 5); scr[kk * 33 + (lane & 31)] = W[(size_t)(k0 + kk) * N + n0 + (lane & 31)]; }
    LDS_WAIT(); asm volatile("" ::: "memory");
    const int c = lane & 7;
#pragma unroll
    for (int j = 0; j < 4; ++j) { const int n = (lane >> 3) + 8 * j; const LAS float* s = scr + (8 * c) * 33 + n;
        u32x4 o; o.x = pk2(s[0 * 33], s[1 * 33]); o.y = pk2(s[2 * 33], s[3 * 33]); o.z = pk2(s[4 * 33], s[5 * 33]); o.w = pk2(s[6 * 33], s[7 * 33]);
        *(u32x4*)(WT + (size_t)(drow0 + n) * K + k0 + 8 * c) = o; }
    LDS_WAIT(); asm volatile("" ::: "memory");
}
__device__ __forceinline__ void p0_prologue(const Args& a, LAS unsigned char* lds, int wave, int lane, int G) {
    LAS float* scr = (LAS float*)(lds + wave * 16384);
    const int gw = blockIdx.x * NWAVES + wave, NGW = G * NWAVES;
    unsigned char* ws = a.ws;
    constexpr int I_IN = (D / 64) * (NIN / 32), I_G = (D / 64) * (FF / 32), I_D = (FF / 64) * (D / 32), I_O = (D / 64) * (D / 32), I_A = (HW / 64) * (D / 32);
    constexpr int NITEMS = I_IN + 2 * I_G + I_D + I_O + 2 * I_A;
    for (int it = gw; it < NITEMS; it += NGW) {
        int r = it;
        if (r < I_IN) { const int nb = NIN / 32, kb = r / nb, n0 = 32 * (r % nb); transpose_item(a.w_in, D, NIN, (bf16*)(ws + WS_WIN), 64 * kb, n0, n0, scr, lane); continue; } r -= I_IN;
        if (r < I_G) { const int nb = FF / 32, kb = r / nb, n0 = 32 * (r % nb); transpose_item(a.w_ffn_gate, D, FF, (bf16*)(ws + WS_WGU), 64 * kb, n0, (n0 >> 7) * 256 + (n0 & 127), scr, lane); continue; } r -= I_G;
        if (r < I_G) { const int nb = FF / 32, kb = r / nb, n0 = 32 * (r % nb); transpose_item(a.w_ffn_up, D, FF, (bf16*)(ws + WS_WGU), 64 * kb, n0, (n0 >> 7) * 256 + 128 + (n0 & 127), scr, lane); continue; } r -= I_G;
        if (r < I_D) { const int nb = D / 32, kb = r / nb, n0 = 32 * (r % nb); transpose_item(a.w_ffn_down, FF, D, (bf16*)(ws + WS_WD), 64 * kb, n0, n0, scr, lane); continue; } r -= I_D;
        if (r < I_O) { const int nb = D / 32, kb = r / nb, n0 = 32 * (r % nb); transpose_item(a.w_out, D, D, (bf16*)(ws + WS_WO), 64 * kb, n0, n0, scr, lane); continue; } r -= I_O;
        if (r < I_A) { const int nb = D / 32, kb = r / nb, n0 = 32 * (r % nb); transpose_item(a.w_branch_a, HW, D, (bf16*)(ws + WS_WA), 64 * kb, n0, n0, scr, lane); continue; } r -= I_A;
        { const int nb = D / 32, kb = r / nb, n0 = 32 * (r % nb); transpose_item(a.w_branch_b, HW, D, (bf16*)(ws + WS_WB), 64 * kb, n0, n0, scr, lane); }
    }
    bf16* XN = (bf16*)a.out;
    f32x4 gm[4];
#pragma unroll
    for (int j = 0; j < 4; ++j) gm[j] = ((const f32x4*)a.norm_mix_g)[lane + 64 * j];
    for (int m = gw; m < M; m += NGW) {
        const f32x4* xr = (const f32x4*)(a.x + (size_t)m * D) + lane;
        f32x4 v[4]; float s = 0.f;
#pragma unroll
        for (int j = 0; j < 4; ++j) { v[j] = xr[64 * j]; s += (v[j].x * v[j].x + v[j].y * v[j].y) + (v[j].z * v[j].z + v[j].w * v[j].w); }
        const float rstd = rsqrtf(wave_sum(s) * (1.0f / D) + EPS);
        u32x2* o8 = (u32x2*)(XN + (size_t)m * D) + lane;
#pragma unroll
        for (int j = 0; j < 4; ++j) { const f32x4 t = v[j] * rstd * gm[j]; u32x2 w; w.x = pk2(t.x, t.y); w.y = pk2(t.z, t.w); o8[64 * j] = w; }
    }
}

constexpr int NAT_P = 272, TR_P = 80;
constexpr int L_QH = 0, L_KH = 8704, L_QI = 17408, L_KOT = 26112, L_VT = 36352, L_DEC = 46592, L_TS = 47104, L_SSQ = 49152;
#define MFMA32(a, b, c) __builtin_amdgcn_mfma_f32_32x32x16_bf16((a), (b), (c), 0, 0, 0)
__device__ __forceinline__ bf16x8 pack8(const f32x16& x, int s) {
    u32x4 p; p.x = pk2(x[8 * s + 0], x[8 * s + 1]); p.y = pk2(x[8 * s + 2], x[8 * s + 3]); p.z = pk2(x[8 * s + 4], x[8 * s + 5]); p.w = pk2(x[8 * s + 6], x[8 * s + 7]);
    return __builtin_bit_cast(bf16x8, p);
}
__device__ __forceinline__ bf16x8 cat4(s16x4 lo, s16x4 hi) { bf16x8 r; r[0] = lo[0]; r[1] = lo[1]; r[2] = lo[2]; r[3] = lo[3]; r[4] = hi[0]; r[5] = hi[1]; r[6] = hi[2]; r[7] = hi[3]; return r; }

template <bool FULL>
__device__ __forceinline__ void scan_item(const Args& a, LAS unsigned char* lds, int item, int tid, int wave, int lane) {
    unsigned char* ws = a.ws;
    const int bh = item >> 4, sc = item & 15, b = bh >> 2, h = bh & 3;
    const int row0 = b * SEQ + sc * 256;
    const int d = tid & 127, tg = tid >> 7;
    const int hf = lane >> 5, l32 = lane & 31, c = wave;
    const float* Gp = (const float*)(ws + WS_G) + (size_t)row0 * HW + h * HD + d;
    const bf16* Qp = (const bf16*)(ws + WS_Q) + (size_t)row0 * HW + h * HD + d;
    const bf16* Vp = (const bf16*)(ws + WS_V) + (size_t)row0 * HW + h * HD + d;
    float* SLOC = (float*)(ws + WS_SLOC); float* DSC = (float*)(ws + WS_DSC);
    f32x16 S[4];
#pragma unroll
    for (int a4 = 0; a4 < 4; ++a4)
#pragma unroll
        for (int r = 0; r < 16; ++r) S[a4][r] = 0.f;
    if (FULL && wave < 4) {
        for (int j = 0; j < sc; ++j) {
            const float* sl = SLOC + ((size_t)(bh * 16 + j) * 4 + c) * 4096 + lane; const float* dj = DSC + (size_t)(bh * 16 + j) * HD;
#pragma unroll
            for (int a4 = 0; a4 < 4; ++a4)
#pragma unroll
                for (int rq = 0; rq < 4; ++rq) { const f32x4 dv = *(const f32x4*)(dj + 32 * a4 + 8 * rq + 4 * hf);
#pragma unroll
                    for (int e = 0; e < 4; ++e) S[a4][4 * rq + e] = dv[e] * S[a4][4 * rq + e] + sl[(a4 * 16 + 4 * rq + e) * 64]; }
        }
    }
    float gl[8], ql[8], vl[8];
#pragma unroll
    for (int s = 0; s < 8; ++s) { const size_t o = (size_t)(8 * tg + s) * HW; gl[s] = Gp[o]; vl[s] = bflo((unsigned)Vp[o]); ql[s] = FULL ? bflo((unsigned)Qp[o]) : 0.f; }
    float dtot = 0.f;
    for (int ch = 0; ch < 8; ++ch) {
        float g[8], q[8], v[8];
#pragma unroll
        for (int s = 0; s < 8; ++s) { g[s] = gl[s]; q[s] = ql[s]; v[s] = vl[s]; }
        if (ch < 7) {
#pragma unroll
            for (int s = 0; s < 8; ++s) { const size_t o = (size_t)((ch + 1) * 32 + 8 * tg + s) * HW; gl[s] = Gp[o]; vl[s] = bflo((unsigned)Vp[o]); ql[s] = FULL ? bflo((unsigned)Qp[o]) : 0.f; }
        }
        float p[8]; p[0] = g[0];
#pragma unroll
        for (int s = 1; s < 8; ++s) p[s] = p[s - 1] + g[s];
        LAS float* TS = (LAS float*)(lds + L_TS);
        TS[tg * 128 + d] = p[7];
        __syncthreads();
        const float t0 = TS[d], t1 = TS[128 + d], t2 = TS[256 + d], t3 = TS[384 + d];
        const float off = (tg > 0 ? t0 : 0.f) + (tg > 1 ? t1 : 0.f) + (tg > 2 ? t2 : 0.f);
        const float blast = (t0 + t1) + (t2 + t3), anchor = t0 + t1;
        float ko[8];
#pragma unroll
        for (int s = 0; s < 8; ++s) {
            const float bs = off + p[s], kk = 1.0f - __expf(g[s]);
            ko[s] = kk * __expf(blast - bs);
            if (FULL) {
                const int t = 8 * tg + s;
                *(LAS bf16*)(lds + L_QH + t * NAT_P + d * 2) = f2bf(q[s] * __expf(bs - anchor));
                *(LAS bf16*)(lds + L_KH + t * NAT_P + d * 2) = f2bf(kk * __expf(anchor - bs));
                *(LAS bf16*)(lds + L_QI + t * NAT_P + d * 2) = f2bf(q[s] * __expf(bs));
            }
        }
        { u32x4 w; w.x = pk2(ko[0], ko[1]); w.y = pk2(ko[2], ko[3]); w.z = pk2(ko[4], ko[5]); w.w = pk2(ko[6], ko[7]); *(LAS u32x4*)(lds + L_KOT + d * TR_P + tg * 16) = w; }
        { u32x4 w; w.x = pk2(v[0], v[1]); w.y = pk2(v[2], v[3]); w.z = pk2(v[4], v[5]); w.w = pk2(v[6], v[7]); *(LAS u32x4*)(lds + L_VT + d * TR_P + tg * 16) = w; }
        if (tg == 0) *(LAS float*)(lds + L_DEC + d * 4) = __expf(blast);
        dtot += blast;
        __syncthreads();
        f32x16 oT;
        if (wave < 4) {
            if (FULL) {
                f32x16 sT;
#pragma unroll
                for (int r = 0; r < 16; ++r) { sT[r] = 0.f; oT[r] = 0.f; }
#pragma unroll
                for (int ks = 0; ks < 8; ++ks) {
                    const bf16x8 ka = *(const LAS bf16x8*)(lds + L_KH + l32 * NAT_P + (16 * ks + 8 * hf) * 2);
                    const bf16x8 qb = *(const LAS bf16x8*)(lds + L_QH + l32 * NAT_P + (16 * ks + 8 * hf) * 2);
                    sT = MFMA32(ka, qb, sT);
                }
#pragma unroll
                for (int r = 0; r < 16; ++r) { const int j = (r & 3) + 8 * (r >> 2) + 4 * hf; if (j > l32) sT[r] = 0.f; }
#pragma unroll
                for (int ks = 0; ks < 2; ++ks) {
                    const s16x4 lo = *(const LAS s16x4*)(lds + L_VT + (32 * c + l32) * TR_P + (16 * ks + 4 * hf) * 2);
                    const s16x4 hi = *(const LAS s16x4*)(lds + L_VT + (32 * c + l32) * TR_P + (16 * ks + 8 + 4 * hf) * 2);
                    oT = MFMA32(cat4(lo, hi), pack8(sT, ks), oT);
                }
#pragma unroll
                for (int a4 = 0; a4 < 4; ++a4)
#pragma unroll
                    for (int ks = 0; ks < 2; ++ks) {
                        const s16x4 lo = *(const LAS s16x4*)(lds + L_QI + l32 * NAT_P + (32 * a4 + 16 * ks + 4 * hf) * 2);
                        const s16x4 hi = *(const LAS s16x4*)(lds + L_QI + l32 * NAT_P + (32 * a4 + 16 * ks + 8 + 4 * hf) * 2);
                        oT = MFMA32(pack8(S[a4], ks), cat4(lo, hi), oT);
                    }
            }
#pragma unroll
            for (int a4 = 0; a4 < 4; ++a4) {
#pragma unroll
                for (int rq = 0; rq < 4; ++rq) { const f32x4 dv = *(const LAS f32x4*)(lds + L_DEC + (32 * a4 + 8 * rq + 4 * hf) * 4);
#pragma unroll
                    for (int e = 0; e < 4; ++e) S[a4][4 * rq + e] *= dv[e]; }
#pragma unroll
                for (int ks = 0; ks < 2; ++ks) {
                    const bf16x8 ka = *(const LAS bf16x8*)(lds + L_KOT + (32 * a4 + l32) * TR_P + (16 * ks + 8 * hf) * 2);
                    const bf16x8 vb = *(const LAS bf16x8*)(lds + L_VT + (32 * c + l32) * TR_P + (16 * ks + 8 * hf) * 2);
                    S[a4] = MFMA32(ka, vb, S[a4]);
                }
            }
            if (FULL) {
                float ssq = 0.f;
#pragma unroll
                for (int r = 0; r < 16; ++r) ssq += oT[r] * oT[r];
                ssq += __shfl_xor(ssq, 32);
                if (lane < 32) *(LAS float*)(lds + L_SSQ + (c * 32 + l32) * 4) = ssq;
            }
        }
        if (FULL) {
            __syncthreads();
            if (wave < 4) {
                const LAS float* SQ = (const LAS float*)(lds + L_SSQ);
                const float tot = (SQ[l32] + SQ[32 + l32]) + (SQ[64 + l32] + SQ[96 + l32]);
                const float rstd = rsqrtf(tot * (1.0f / HD) + EPS);
                const size_t ro = (size_t)(row0 + ch * 32 + l32) * HW + h * HD;
#pragma unroll
                for (int rq = 0; rq < 4; ++rq) { const int dv0 = 32 * c + 8 * rq + 4 * hf;
                    const u32x2 gs = *(const u32x2*)((const bf16*)(ws + WS_GS) + ro + dv0); const f32x4 ng = *(const f32x4*)(a.hg_norm_g + dv0);
                    const float o0 = oT[4 * rq + 0] * rstd * ng[0] * bflo(gs.x), o1 = oT[4 * rq + 1] * rstd * ng[1] * bfhi(gs.x);
                    const float o2 = oT[4 * rq + 2] * rstd * ng[2] * bflo(gs.y), o3 = oT[4 * rq + 3] * rstd * ng[3] * bfhi(gs.y);
                    u32x2 w; w.x = pk2(o0, o1); w.y = pk2(o2, o3);
                    *(u32x2*)((bf16*)(ws + WS_HG) + ro + dv0) = w; }
            }
        }
    }
    if (!FULL) {
        if (wave < 4) { float* sl = SLOC + ((size_t)item * 4 + c) * 4096 + lane;
#pragma unroll
            for (int a4 = 0; a4 < 4; ++a4)
#pragma unroll
                for (int r = 0; r < 16; ++r) sl[(a4 * 16 + r) * 64] = S[a4][r]; }
        if (tg == 0) DSC[(size_t)item * HD + d] = __expf(dtot);
    }
    __syncthreads();
}
__device__ __forceinline__ void conv_items(const Args& a, int tid, int G) {
    unsigned char* ws = a.ws;
    const bf16* CG = (const bf16*)(ws + WS_CG); const bf16* XB = (const bf16*)(ws + WS_XB); bf16* BG = (bf16*)(ws + WS_BG);
    for (int it = blockIdx.x * NTHR + tid; it < (M / 8) * (HW / 8); it += G * NTHR) {
        const int tgp = it >> 6, c0 = (it & 63) * 8, t0 = tgp * 8;
        float w0[8], w1[8], w2[8], um2[8], um1[8];
#pragma unroll
        for (int e = 0; e < 8; ++e) { w0[e] = a.conv_w[c0 + e]; w1[e] = a.conv_w[HW + c0 + e]; w2[e] = a.conv_w[2 * HW + c0 + e]; um2[e] = 0.f; um1[e] = 0.f; }
        if ((t0 & (SEQ - 1)) != 0) {
            const u32x4 ca = *(const u32x4*)(CG + (size_t)(t0 - 2) * HW + c0), xa = *(const u32x4*)(XB + (size_t)(t0 - 2) * HW + c0);
            const u32x4 cb = *(const u32x4*)(CG + (size_t)(t0 - 1) * HW + c0), xb = *(const u32x4*)(XB + (size_t)(t0 - 1) * HW + c0);
#pragma unroll
            for (int e = 0; e < 4; ++e) { um2[2 * e] = bflo(ca[e]) * bflo(xa[e]); um2[2 * e + 1] = bfhi(ca[e]) * bfhi(xa[e]); um1[2 * e] = bflo(cb[e]) * bflo(xb[e]); um1[2 * e + 1] = bfhi(cb[e]) * bfhi(xb[e]); }
        }
#pragma unroll
        for (int s = 0; s < 8; ++s) {
            const size_t ro = (size_t)(t0 + s) * HW + c0;
            const u32x4 cc = *(const u32x4*)(CG + ro), xx = *(const u32x4*)(XB + ro), bb = *(const u32x4*)(BG + ro);
            float u[8], o[8];
#pragma unroll
            for (int e = 0; e < 4; ++e) { u[2 * e] = bflo(cc[e]) * bflo(xx[e]); u[2 * e + 1] = bfhi(cc[e]) * bfhi(xx[e]); }
#pragma unroll
            for (int e = 0; e < 8; ++e) { const float y = w0[e] * um2[e] + w1[e] * um1[e] + w2[e] * u[e]; o[e] = y * ((e & 1) ? bfhi(bb[e >> 1]) : bflo(bb[e >> 1])); um2[e] = um1[e]; um1[e] = u[e]; }
            u32x4 w; w.x = pk2(o[0], o[1]); w.y = pk2(o[2], o[3]); w.z = pk2(o[4], o[5]); w.w = pk2(o[6], o[7]);
            *(u32x4*)(BG + ro) = w;
        }
    }
}
__device__ __forceinline__ void final_norm(const Args& a, int wave, int lane, int G) {
    const float* ss = (const float*)(a.ws + WS_SS2);
    f32x4 gm[4];
#pragma unroll
    for (int j = 0; j < 4; ++j) gm[j] = ((const f32x4*)a.norm_final_g)[lane + 64 * j];
    for (int m = blockIdx.x * NWAVES + wave; m < M; m += G * NWAVES) {
        const f32x4* sp = (const f32x4*)(ss + (size_t)m * 16); const f32x4 s4 = (sp[0] + sp[1]) + (sp[2] + sp[3]);
        const float rstd = rsqrtf(((s4[0] + s4[1]) + (s4[2] + s4[3])) * (1.0f / D) + EPS);
        f32x4* xr = (f32x4*)(a.out + (size_t)m * D) + lane;
#pragma unroll
        for (int j = 0; j < 4; ++j) xr[64 * j] = xr[64 * j] * rstd * gm[j];
    }
}

__global__ void __launch_bounds__(NTHR, 2) hybrid_fwd(Args a) {
    extern __shared__ __attribute__((aligned(16))) unsigned char lds_raw[];
    LAS unsigned char* lds = (LAS unsigned char*)lds_raw;
    cg::grid_group grid = cg::this_grid();
    const int tid = threadIdx.x, lane = tid & 63, wave = __builtin_amdgcn_readfirstlane(tid >> 6), G = gridDim.x;
    unsigned char* ws = a.ws;
    unsigned* barw = (unsigned*)(ws + WS_BAR);
    if (tid < 2) ((LAS unsigned*)(lds + LDS_ST_OFF))[tid] = 0u;
    if (blockIdx.x == 0) for (int i = tid; i < XCD_BAR_WORDS; i += NTHR) __hip_atomic_store(barw + i, 0u, __ATOMIC_RELAXED, __HIP_MEMORY_SCOPE_AGENT);
    __syncthreads();
    p0_prologue(a, lds, wave, lane, G);
    grid.sync();
    const XcdBarrier bar = xcd_barrier_post(barw, (volatile LAS unsigned*)(lds + LDS_ST_OFF));
    { pg8::Gemm g{(const bf16*)a.out, (const bf16*)(ws + WS_WIN), nullptr, nullptr, M, NIN, D}; pg8::StaticOrder S; S.init(M, NIN, G, (int)blockIdx.x);
      EpiProj E{ws, a.lower_bounds};
      pg8::gemm_phase<EpiProj, pg8::StaticOrder, PG8_ALIGN, PG8_SP2>(lds, g, S, E); }
    xcd_barrier(bar);
    for (int item = blockIdx.x; item < 256; item += G) scan_item<false>(a, lds, item, tid, wave, lane);
    conv_items(a, tid, G);
    xcd_barrier(bar);
    for (int item = blockIdx.x; item < 256; item += G) scan_item<true>(a, lds, item, tid, wave, lane);
    xcd_barrier(bar);
    { pg8::Gemm g{(const bf16*)(ws + WS_HG), (const bf16*)(ws + WS_WA), (const bf16*)(ws + WS_CV), (const bf16*)(ws + WS_WB), M, D, HW}; pg8::StaticOrder S; S.init(M, D, G, (int)blockIdx.x, 1);
      EpiBranch E{(const bf16*)(ws + WS_GA), (const bf16*)(ws + WS_GB), (bf16*)(ws + WS_MG)};
      pg8::gemm_phase<EpiBranch, pg8::StaticOrder, PG8_ALIGN, PG8_SP2>(lds, g, S, E); }
    xcd_barrier(bar);
    { pg8::Gemm g{(const bf16*)(ws + WS_MG), (const bf16*)(ws + WS_WO), nullptr, nullptr, M, D, D}; pg8::StaticOrder S; S.init(M, D, G, (int)blockIdx.x);
      EpiRes<true> E{a.x, a.out, (bf16*)(ws + WS_XN2), a.norm_ffn_g, (float*)(ws + WS_SS1)};
      pg8::gemm_phase<EpiRes<true>, pg8::StaticOrder, PG8_ALIGN, PG8_SP2>(lds, g, S, E); }
    xcd_barrier(bar);
    { pg8::Gemm g{(const bf16*)(ws + WS_XN2), (const bf16*)(ws + WS_WGU), nullptr, nullptr, M, 2 * FF, D}; pg8::StaticOrder S; S.init(M, 2 * FF, G, (int)blockIdx.x);
      EpiGU E{(const float*)(ws + WS_SS1), (bf16*)(ws + WS_H)};
      pg8::gemm_phase<EpiGU, pg8::StaticOrder, PG8_ALIGN, PG8_SP2>(lds, g, S, E); }
    xcd_barrier(bar);
    { pg8::Gemm g{(const bf16*)(ws + WS_H), (const bf16*)(ws + WS_WD), nullptr, nullptr, M, D, FF}; pg8::StaticOrder S; S.init(M, D, G, (int)blockIdx.x);
      EpiRes<false> E{a.out, a.out, nullptr, nullptr, (float*)(ws + WS_SS2)};
      pg8::gemm_phase<EpiRes<false>, pg8::StaticOrder, PG8_ALIGN, PG8_SP2>(lds, g, S, E); }
    xcd_barrier(bar);
    final_norm(a, wave, lane, G);
}

extern "C" void kernel_launch(void* const* d_in, const int* in_sizes, int n_in, void* d_out, int out_size, void* d_ws, size_t ws_size, hipStream_t stream) {
    static int grid = 0;
    if (grid == 0) {
        if (n_in != 14 || out_size != M * D || ws_size < WS_END) { fprintf(stderr, "kernel_launch: unexpected shapes (n_in %d out %d ws %zu)\n", n_in, out_size, ws_size); grid = -1; return; }
        int dev = 0, cus = 0, per_cu = 0;
        (void)hipGetDevice(&dev);
        (void)hipDeviceGetAttribute(&cus, hipDeviceAttributeMultiprocessorCount, dev);
        (void)hipFuncSetAttribute((const void*)hybrid_fwd, hipFuncAttributeMaxDynamicSharedMemorySize, LDS_BYTES);
        (void)hipOccupancyMaxActiveBlocksPerMultiprocessor(&per_cu, (const void*)hybrid_fwd, NTHR, LDS_BYTES);
        if (per_cu < 1) { fprintf(stderr, "kernel_launch: occupancy query reports %d blocks per CU\n", per_cu); grid = -1; return; }
        grid = cus;
    }
    if (grid < 0) return;
    Args a{};
    a.x = (const float*)d_in[0]; a.norm_mix_g = (const float*)d_in[1]; a.w_in = (const float*)d_in[2]; a.lower_bounds = (const float*)d_in[3]; a.hg_norm_g = (const float*)d_in[4];
    a.conv_w = (const float*)d_in[5]; a.w_branch_a = (const float*)d_in[6]; a.w_branch_b = (const float*)d_in[7]; a.w_out = (const float*)d_in[8]; a.norm_ffn_g = (const float*)d_in[9];
    a.w_ffn_gate = (const float*)d_in[10]; a.w_ffn_up = (const float*)d_in[11]; a.w_ffn_down = (const float*)d_in[12]; a.norm_final_g = (const float*)d_in[13];
    a.out = (float*)d_out; a.ws = (unsigned char*)d_ws;
    void* args[] = {&a};
    hipError_t e = hipLaunchCooperativeKernel((const void*)hybrid_fwd, dim3(grid), dim3(NTHR), args, LDS_BYTES, stream);
    if (e != hipSuccess) fprintf(stderr, "kernel_launch: cooperative launch failed: %s (grid %d)\n", hipGetErrorString(e), grid);
}
```

```cpp
#include <hip/hip_runtime.h>
#include <hip/hip_cooperative_groups.h>
#include <cstdio>
#include <cstdint>
namespace cg = cooperative_groups;
namespace pg8 {
#define PG8_LAS __attribute__((address_space(3)))
typedef unsigned short bf16_t;
typedef short bf16x8 __attribute__((ext_vector_type(8)));
typedef float f32x4 __attribute__((ext_vector_type(4)));
typedef unsigned u32x4 __attribute__((ext_vector_type(4)));
constexpr int BM = 256, BK = 64, HALF = 128, HTB = HALF * BK * 2  , STAGE_BYTES = 8 * HTB, NXCD = 8, WGM = 8;

__host__ __device__ __forceinline__ int lds_byte(int r, int c) { const int st = (r >> 4) * 2 + (c >> 5), rr = r & 15, cc = c & 31, ob = rr * 64 + cc * 2; return st * 1024 + (ob ^ (((ob >> 9) & 1) << 5)); }
__host__ __device__ __forceinline__ void stage_rc(int b, int& R, int& C) { const int st = b / 1024, sb = b % 1024, swz = sb ^ (((sb >> 9) & 1) << 5); R = (st >> 1) * 16 + swz / 64; C = (st & 1) * 32 + (swz % 64) / 2; }
__host__ __device__ __forceinline__ int perm32(int rho) { const int n = rho >> 4, i = rho & 15; return 8 * (i >> 2) + 4 * n + (i & 3); }

struct Unit { int pm, pn, sel; };
struct Gemm { const bf16_t* A; const bf16_t* Bt; const bf16_t* A2; const bf16_t* Bt2; int M, N, K; };

struct StaticOrder {
    int nM, nN, nwg, G, c, dual;
    __host__ __device__ void init(int M, int N, int G_, int c_, int dual_ = 0) { nM = M / BM; nN = N / BM; nwg = nM * nN; G = G_; c = c_; dual = dual_; }
    __host__ __device__ bool next(int i_, Unit& u) const {
        const int i = dual ? (i_ >> 1) : i_; u.sel = dual ? (i_ & 1) : 0;
        const long L = (long)i * G + c; if (L >= nwg) return false;
        int wgid = (int)L; { const int q = nwg / NXCD, r = nwg % NXCD, xcd = wgid % NXCD, off = wgid / NXCD; wgid = (xcd < r ? xcd * (q + 1) : r * (q + 1) + (xcd - r) * q) + off; }
        const int nig = WGM * nN, gid = wgid / nig, fm = gid * WGM, gsz = (nM - fm) < WGM ? (nM - fm) : WGM;
        u.pm = fm + ((wgid % nig) % gsz); u.pn = (wgid % nig) / gsz; return true;
    }
    __device__ __forceinline__ void a_ready(const Unit&) const {}
    __device__ __forceinline__ void done(const Unit&) const {}
};

__device__ __forceinline__ unsigned cvt_pk_bf16(float lo, float hi) { unsigned r; asm volatile("v_cvt_pk_bf16_f32 %0, %1, %2" : "=v"(r) : "v"(lo), "v"(hi)); return r; }
template <class Epi, class Sched, bool ALIGN_EPI = false, bool SP2 = false>
__device__ __forceinline__ void gemm_phase(PG8_LAS unsigned char* lds, const Gemm g, const Sched& S, const Epi& E) {
    const int tid = threadIdx.x, wid = __builtin_amdgcn_readfirstlane(tid >> 6), lane = tid & 63, wr = wid >> 2, wc = wid & 3, fr = lane & 15, fq = lane >> 4;
    const int K = g.K, nt = K / BK;
    unsigned voffA[2], voffB[2];
#pragma unroll
    for (int i = 0; i < 2; ++i) { int R, C; stage_rc(tid * 16 + i * 8192, R, C); const int Rb = Epi::PERM ? ((R & ~31) + perm32(R & 31)) : R;
        voffA[i] = (unsigned)(R * K + C) * 2u; voffB[i] = (unsigned)(Rb * K + C) * 2u; }
    const size_t kstep = (size_t)(BK * 2);
    const size_t hstep = (size_t)HALF * K * 2;
    const size_t tstep = 2 * hstep;
    const unsigned ldsw = (unsigned)wid * 1024u;
    const int aoff = lds_byte(wr * 64 + fr, fq * 8), boff = lds_byte(wc * 32 + fr, fq * 8);
#define PG8_SA(b, h) (((b) * 2 + (h)) * HTB)
#define PG8_SB(b, h) ((4 + (b) * 2 + (h)) * HTB)
#define PG8_STAGE(bufoff, gbase, voff) do { _Pragma("unroll") for (int _i = 0; _i < 2; ++_i) \
        __builtin_amdgcn_global_load_lds((const unsigned*)((const char*)(gbase) + (voff)[_i]), (PG8_LAS unsigned*)(lds + (bufoff) + ldsw + _i * 8192), 16, 0, 0); } while (0)
#define PG8_LDA(dst, b, h) do { _Pragma("unroll") for (int m = 0; m < 4; ++m) _Pragma("unroll") for (int k = 0; k < 2; ++k) dst[m][k] = *(const PG8_LAS bf16x8*)(lds + PG8_SA(b, h) + aoff + m * 2048 + k * 1024); } while (0)
#define PG8_LDB(dst, b, h) do { _Pragma("unroll") for (int n = 0; n < 2; ++n) _Pragma("unroll") for (int k = 0; k < 2; ++k) dst[n][k] = *(const PG8_LAS bf16x8*)(lds + PG8_SB(b, h) + boff + n * 2048 + k * 1024); } while (0)
#define PG8_MMA(ai, bj, At, Bt) do { __builtin_amdgcn_s_setprio(1); _Pragma("unroll") for (int m = 0; m < 4; ++m) _Pragma("unroll") for (int n = 0; n < 2; ++n) _Pragma("unroll") for (int k = 0; k < 2; ++k) \
        acc[ai][bj][m][n] = __builtin_amdgcn_mfma_f32_16x16x32_bf16(Bt[n][k], At[m][k], acc[ai][bj][m][n], 0, 0, 0); __builtin_amdgcn_s_setprio(0); } while (0)
#define PG8_WAIT_V(n) asm volatile("s_waitcnt vmcnt(" #n ")" ::: "memory")
#define PG8_WAIT_L(n) asm volatile("s_waitcnt lgkmcnt(" #n ")" ::: "memory")
#define PG8_BAR __builtin_amdgcn_s_barrier()
#define PG8_SCHED __builtin_amdgcn_sched_barrier(0)
    Unit cur, nxt; int ui = 0;
    if (!S.next(0, cur)) return;
    f32x4 acc[2][2][4][2];
#pragma unroll
    for (int a = 0; a < 2; ++a)
#pragma unroll
        for (int b = 0; b < 2; ++b)
#pragma unroll
            for (int m = 0; m < 4; ++m)
#pragma unroll
                for (int n = 0; n < 2; ++n) acc[a][b][m][n] = (f32x4){0.f, 0.f, 0.f, 0.f};
    bf16x8 At[4][2], B0[2][2], B1[2][2];
    const char* cA = (const char*)(cur.sel ? g.A2 : g.A) + (size_t)cur.pm * tstep; const char* cB = (const char*)(cur.sel ? g.Bt2 : g.Bt) + (size_t)cur.pn * tstep;
    S.a_ready(cur);
    if constexpr (SP2) {
        PG8_STAGE(PG8_SB(0, 0), cB, voffB); PG8_STAGE(PG8_SB(0, 1), cB + hstep, voffB); PG8_STAGE(PG8_SA(0, 0), cA, voffA); PG8_STAGE(PG8_SA(0, 1), cA + hstep, voffA);
        if (wr == 1) PG8_BAR;
        PG8_WAIT_V(2); PG8_BAR;
        PG8_STAGE(PG8_SB(1, 0), cB + kstep, voffB); PG8_STAGE(PG8_SA(1, 0), cA + kstep, voffA); PG8_STAGE(PG8_SB(1, 1), cB + hstep + kstep, voffB);
        PG8_WAIT_V(6); PG8_BAR;
    } else {
        PG8_STAGE(PG8_SB(0, 0), cB, voffB); PG8_STAGE(PG8_SA(0, 0), cA, voffA); PG8_STAGE(PG8_SB(0, 1), cB + hstep, voffB); PG8_STAGE(PG8_SA(0, 1), cA + hstep, voffA);
        if (wr == 1) PG8_BAR;
        PG8_WAIT_V(4); PG8_BAR;
        PG8_STAGE(PG8_SB(1, 0), cB + kstep, voffB); PG8_STAGE(PG8_SA(1, 0), cA + kstep, voffA); PG8_STAGE(PG8_SB(1, 1), cB + hstep + kstep, voffB);
        PG8_WAIT_V(6); PG8_BAR;
    }
    for (;;) {
        const bool has_next = S.next(ui + 1, nxt);
        const char* nA = has_next ? (const char*)(nxt.sel ? g.A2 : g.A) + (size_t)nxt.pm * tstep : cA; const char* nB = has_next ? (const char*)(nxt.sel ? g.Bt2 : g.Bt) + (size_t)nxt.pn * tstep : cB;
        for (int t = 0; t < nt; t += 2) {
            const bool last = (t == nt - 2);
            const char* a1 = cA + (size_t)(t + 1) * kstep;
            const char* a2 = last ? nA : cA + (size_t)(t + 2) * kstep; const char* b2 = last ? nB : cB + (size_t)(t + 2) * kstep;
            const char* a3 = a2 + kstep; const char* b3 = b2 + kstep;
            if (last && has_next) S.a_ready(nxt);
            if constexpr (SP2) {
            PG8_LDB(B0, 0, 0); PG8_LDB(B1, 0, 1); PG8_SCHED; PG8_LDA(At, 0, 0); PG8_STAGE(PG8_SA(1, 1), a1 + hstep, voffA);
            PG8_WAIT_V(8); PG8_WAIT_L(0); PG8_BAR; PG8_MMA(0, 0, At, B0); PG8_MMA(0, 1, At, B1); PG8_BAR; PG8_SCHED;
            PG8_LDA(At, 0, 1); PG8_STAGE(PG8_SB(0, 0), b2, voffB); PG8_STAGE(PG8_SB(0, 1), b2 + hstep, voffB); PG8_STAGE(PG8_SA(0, 0), a2, voffA);
            PG8_WAIT_V(8); PG8_WAIT_L(0); PG8_BAR; PG8_MMA(1, 0, At, B0); PG8_MMA(1, 1, At, B1); PG8_BAR; PG8_SCHED;
            PG8_LDB(B0, 1, 0); PG8_LDB(B1, 1, 1); PG8_SCHED; PG8_LDA(At, 1, 0); PG8_STAGE(PG8_SA(0, 1), a2 + hstep, voffA);
            PG8_WAIT_V(8); PG8_WAIT_L(0); PG8_BAR; PG8_MMA(0, 0, At, B0); PG8_MMA(0, 1, At, B1); PG8_BAR; PG8_SCHED;
            PG8_LDA(At, 1, 1); PG8_STAGE(PG8_SB(1, 0), b3, voffB); PG8_STAGE(PG8_SB(1, 1), b3 + hstep, voffB); PG8_STAGE(PG8_SA(1, 0), a3, voffA);
            PG8_WAIT_V(8); PG8_WAIT_L(0); PG8_BAR; PG8_MMA(1, 0, At, B0); PG8_MMA(1, 1, At, B1); PG8_BAR; PG8_SCHED;
            } else {
            PG8_LDB(B0, 0, 0); PG8_SCHED; PG8_LDA(At, 0, 0); PG8_STAGE(PG8_SA(1, 1), a1 + hstep, voffA);
            PG8_WAIT_L(8); PG8_BAR; PG8_WAIT_L(0); PG8_MMA(0, 0, At, B0); PG8_BAR; PG8_SCHED;
            PG8_LDB(B1, 0, 1); PG8_STAGE(PG8_SB(0, 0), b2, voffB);
            PG8_BAR; PG8_WAIT_L(0); PG8_MMA(0, 1, At, B1); PG8_BAR;
            PG8_LDA(At, 0, 1); PG8_STAGE(PG8_SA(0, 0), a2, voffA);
            PG8_BAR; PG8_WAIT_L(0); PG8_MMA(1, 0, At, B0); PG8_BAR; PG8_SCHED;
            PG8_STAGE(PG8_SB(0, 1), b2 + hstep, voffB);
            PG8_WAIT_V(6); PG8_BAR; PG8_MMA(1, 1, At, B1); PG8_BAR;
            PG8_LDB(B0, 1, 0); PG8_SCHED; PG8_LDA(At, 1, 0); PG8_STAGE(PG8_SA(0, 1), a2 + hstep, voffA);
            PG8_WAIT_L(8); PG8_BAR; PG8_WAIT_L(0); PG8_MMA(0, 0, At, B0); PG8_BAR; PG8_SCHED;
            PG8_LDB(B1, 1, 1); PG8_STAGE(PG8_SB(1, 0), b3, voffB);
            PG8_BAR; PG8_WAIT_L(0); PG8_MMA(0, 1, At, B1); PG8_BAR;
            PG8_LDA(At, 1, 1); PG8_STAGE(PG8_SA(1, 0), a3, voffA);
            PG8_BAR; PG8_WAIT_L(0); PG8_MMA(1, 0, At, B0); PG8_BAR; PG8_SCHED;
            PG8_STAGE(PG8_SB(1, 1), b3 + hstep, voffB);
            PG8_WAIT_V(6); PG8_BAR; PG8_MMA(1, 1, At, B1); PG8_BAR;
            }
        }
        if constexpr (ALIGN_EPI) { if (wr == 0) PG8_BAR; }
        bool keep = false; if constexpr (!Epi::AFTER_DRAIN) { keep = E(acc, cur, wr, wc, fr, fq); S.done(cur); }
        if (!has_next) break;
        if (!keep) {
#pragma unroll
        for (int a = 0; a < 2; ++a)
#pragma unroll
            for (int b = 0; b < 2; ++b)
#pragma unroll
                for (int m = 0; m < 4; ++m)
#pragma unroll
                    for (int n = 0; n < 2; ++n) acc[a][b][m][n] = (f32x4){0.f, 0.f, 0.f, 0.f};
        }
        cur = nxt; cA = nA; cB = nB; ++ui;
        if constexpr (ALIGN_EPI) { if (wr == 1) PG8_BAR; }
    }
    PG8_WAIT_V(0);
    if constexpr (!ALIGN_EPI) { if (wr == 0) PG8_BAR; }
    PG8_BAR;
    if constexpr (Epi::AFTER_DRAIN) { E.fused(acc, cur, wr, wc, fr, fq, lds, wid, lane); S.done(cur); }
#undef PG8_SA
#undef PG8_SB
#undef PG8_STAGE
#undef PG8_LDA
#undef PG8_LDB
#undef PG8_MMA
#undef PG8_WAIT_V
#undef PG8_WAIT_L
#undef PG8_BAR
#undef PG8_SCHED
}
}

#define PG8_SP2 true
#define PG8_ALIGN true

constexpr int NWAVES = 8, NTHR = 512;
constexpr int BATCH = 4, SEQ = 4096, D = 1024, M = BATCH * SEQ, HW = 512, HD = 128, NH = 4, NIN = 5632, FF = 2816;
constexpr float EPS = 1e-6f;
constexpr int LDS_BYTES = 147456;
constexpr size_t MiB = 1u << 20;
constexpr size_t WS_SS1 = 0, WS_SS2 = 1 * MiB, WS_DSC = 2 * MiB, WS_BAR = 3 * MiB;
constexpr int LDS_ST_OFF = 131072 + 320;
constexpr size_t CTL_BYTES = 65536;
constexpr size_t WS_WIN = 4 * MiB, WS_WGU = 15 * MiB, WS_WD = 26 * MiB, WS_WO = 32 * MiB, WS_WA = 34 * MiB, WS_WB = 35 * MiB;
constexpr size_t WS_Q = 36 * MiB, WS_V = 52 * MiB, WS_GS = 68 * MiB, WS_G = 84 * MiB, WS_CG = 116 * MiB, WS_BG = 132 * MiB, WS_XB = 148 * MiB, WS_GA = 164 * MiB, WS_GB = 196 * MiB, WS_SLOC = 228 * MiB;
constexpr size_t WS_CV = WS_BG, WS_HG = WS_CG, WS_MG = WS_Q, WS_XN2 = WS_G, WS_H = WS_CG, WS_END = 244 * MiB;

#define LAS __attribute__((address_space(3)))
typedef unsigned short bf16;
typedef float f32x4 __attribute__((ext_vector_type(4)));
typedef float f32x2 __attribute__((ext_vector_type(2)));
typedef float f32x16 __attribute__((ext_vector_type(16)));
typedef unsigned u32x4 __attribute__((ext_vector_type(4)));
typedef unsigned u32x2 __attribute__((ext_vector_type(2)));
typedef short bf16x8 __attribute__((ext_vector_type(8)));
typedef short s16x4 __attribute__((ext_vector_type(4)));
typedef __bf16 hbf2 __attribute__((ext_vector_type(2)));

__device__ __forceinline__ unsigned pk2(float lo, float hi) { f32x2 v = {lo, hi}; hbf2 b = __builtin_convertvector(v, hbf2); return __builtin_bit_cast(unsigned, b); }
__device__ __forceinline__ unsigned short f2bf(float f) { return (unsigned short)(pk2(f, 0.f) & 0xffffu); }
__device__ __forceinline__ float bflo(unsigned u) { return __uint_as_float(u << 16); }
__device__ __forceinline__ float bfhi(unsigned u) { return __uint_as_float(u & 0xffff0000u); }
__device__ __forceinline__ float sigm(float v) { return __fdividef(1.0f, 1.0f + __expf(-v)); }
__device__ __forceinline__ float silu(float v) { return __fdividef(v, 1.0f + __expf(-v)); }
__device__ __forceinline__ float wave_sum(float v) {
#pragma unroll
    for (int o = 1; o < 64; o <<= 1) v += __shfl_xor(v, o);
    return v;
}
#define LDS_WAIT() asm volatile("s_waitcnt lgkmcnt(0)" ::: "memory")
typedef __attribute__((address_space(1))) unsigned gu32;
#define VM_WAIT() asm volatile("s_waitcnt vmcnt(0)" ::: "memory")
#define XB_TMO      128
#define XB_XCNT(j)  (256  + 64 * (j))
#define XB_XSUB(j)  (1280 + 64 * (j))
#define XB_XGEN(j)  (2304 + 64 * (j))
#define XB_TOP      3328
#define XB_TOPGEN   3392
#define XCD_BAR_WORDS 3456
#define XB_SPIN_CAP (1u << 18)

__device__ __forceinline__ unsigned xb_ld(unsigned* p)              { return __hip_atomic_load(p, __ATOMIC_RELAXED, __HIP_MEMORY_SCOPE_AGENT); }
__device__ __forceinline__ unsigned xb_add(unsigned* p, unsigned v) { return __hip_atomic_fetch_add(p, v, __ATOMIC_RELAXED, __HIP_MEMORY_SCOPE_AGENT); }
__device__ __forceinline__ unsigned xb_xcc_id() { return (unsigned)__builtin_amdgcn_s_getreg((3 << 11) | 20) & 0xFu; }
#define XB_SPIN(cond, bar) do { unsigned _sp = 0; while (cond) { __builtin_amdgcn_s_sleep(1); \
    if ((++_sp & 255u) == 0u) { if (xb_ld(&(bar)[XB_TMO])) break; if (_sp > XB_SPIN_CAP) { atomicAdd(&(bar)[XB_TMO], 1u); break; } } } } while (0)

struct XcdBarrier {
    unsigned* bar; unsigned x;
    volatile LAS unsigned* st;
};

__device__ __forceinline__ XcdBarrier xcd_barrier_post(unsigned* bar, volatile LAS unsigned* st) {
    XcdBarrier b; b.bar = bar; b.x = xb_xcc_id(); b.st = st;
    if (threadIdx.x == 0) (void)xb_add(&bar[XB_XCNT(b.x)], 1u);
    return b;
}
__device__ __forceinline__ void xcd_barrier_complete(unsigned* bar, unsigned x, unsigned& nloc, unsigned& nx) {
    const unsigned G = gridDim.x * gridDim.y * gridDim.z;
    unsigned sum, cnt, mine, sp = 0u;
    for (;;) {
        sum = 0u; cnt = 0u; mine = 0u;
#pragma unroll
        for (unsigned j = 0; j < 16; ++j) { const unsigned c = xb_ld(&bar[XB_XCNT(j)]); sum += c; cnt += (c > 0u) ? 1u : 0u; mine = (j == x) ? c : mine; }
        if (sum == G) break;
        __builtin_amdgcn_s_sleep(1);
        if ((++sp & 255u) == 0u) { if (xb_ld(&bar[XB_TMO])) break; if (sp > XB_SPIN_CAP) { atomicAdd(&bar[XB_TMO], 1u); break; } }
    }
    nloc = mine > 0u ? mine : 1u; nx = cnt > 0u ? cnt : 1u;
}

__device__ __forceinline__ void xcd_barrier(const XcdBarrier& b) {
    asm volatile("s_waitcnt vmcnt(0)" ::: "memory");
    __syncthreads();
    if (threadIdx.x == 0) {
        unsigned* bar = b.bar;
        __builtin_amdgcn_s_waitcnt(0);
        unsigned nloc = b.st[0], nx = b.st[1];
        if (nloc == 0u) { xcd_barrier_complete(bar, b.x, nloc, nx); b.st[0] = nloc; b.st[1] = nx; }
        const unsigned old = xb_add(&bar[XB_XSUB(b.x)], 1u);
        const unsigned gen = old / nloc;
        if (old + 1u == (gen + 1u) * nloc) {
            __builtin_amdgcn_fence(__ATOMIC_RELEASE, "agent");
            asm volatile("s_waitcnt vmcnt(0)" ::: "memory");
            const unsigned og = xb_add(&bar[XB_TOP], 1u);
            const unsigned tg = og / nx;
            if (og + 1u == (tg + 1u) * nx) xb_add(&bar[XB_TOPGEN], 1u);
            else XB_SPIN(xb_ld(&bar[XB_TOPGEN]) == tg, bar);
            __builtin_amdgcn_fence(__ATOMIC_ACQUIRE, "agent");
            xb_add(&bar[XB_XGEN(b.x)], 1u);
            asm volatile("s_waitcnt vmcnt(0)" ::: "memory");
        } else {
            XB_SPIN(xb_ld(&bar[XB_XGEN(b.x)]) == gen, bar);
            __builtin_amdgcn_fence(__ATOMIC_ACQUIRE, "agent");
            asm volatile("s_waitcnt vmcnt(0)" ::: "memory");
        }
    }
    __syncthreads();
}


struct Args {
    const float *x, *norm_mix_g, *w_in, *lower_bounds, *hg_norm_g, *conv_w, *w_branch_a, *w_branch_b, *w_out, *norm_ffn_g, *w_ffn_gate, *w_ffn_up, *w_ffn_down, *norm_final_g;
    float* out; unsigned char* ws; int coop_sync, pad;
};

using pg8::Unit;
struct EpiProj {
    static constexpr bool PERM = true, AFTER_DRAIN = false;
    unsigned char* ws; const float* lbnd;
    __device__ __forceinline__ bool operator()(f32x4 (&acc)[2][2][4][2], const Unit& u, int wr, int wc, int fr, int fq) const {
        const int row0 = u.pm * 256 + wr * 64 + fr, pn = u.pn;
        int mode = 2, ldc = HW, colt; size_t off;
        if (pn < 2) { mode = 0; off = WS_Q; colt = pn * 256; }
        else if (pn < 4) { mode = 1; off = WS_G; colt = (pn - 2) * 256; }
        else if (pn < 6) { off = WS_V; colt = (pn - 4) * 256; }
        else if (pn < 8) { mode = 3; off = WS_GS; colt = (pn - 6) * 256; }
        else if (pn < 10) { off = WS_CG; colt = (pn - 8) * 256; }
        else if (pn < 12) { off = WS_BG; colt = (pn - 10) * 256; }
        else if (pn < 14) { off = WS_XB; colt = (pn - 12) * 256; }
        else if (pn < 18) { off = WS_GA; colt = (pn - 14) * 256; ldc = D; }
        else { off = WS_GB; colt = (pn - 18) * 256; ldc = D; }
        const int col0 = colt + wc * 32 + 8 * fq;
        if (mode == 1) {
            float* G = (float*)(ws + off);
            float lb[2][8];
#pragma unroll
            for (int bj = 0; bj < 2; ++bj)
#pragma unroll
                for (int j = 0; j < 8; ++j) { const int c = col0 + bj * 128 + j; lb[bj][j] = __fdividef(1.0f, 1.0f + __expf(lbnd[HW + c] - lbnd[c])); }
#pragma unroll
            for (int ai = 0; ai < 2; ++ai)
#pragma unroll
                for (int m = 0; m < 4; ++m) { float* rowp = G + (size_t)(row0 + ai * 128 + m * 16) * HW + col0;
#pragma unroll
                    for (int bj = 0; bj < 2; ++bj) {
#pragma unroll
                        for (int n = 0; n < 2; ++n) { f32x4 v = acc[ai][bj][m][n], o;
#pragma unroll
                            for (int e = 0; e < 4; ++e) { const float l = lb[bj][4 * n + e]; o[e] = logf(l + (1.0f - l) * sigm(v[e])); }
                            *(f32x4*)(rowp + bj * 128 + 4 * n) = o; } } }
        } else {
            bf16* O = (bf16*)(ws + off);
#pragma unroll
            for (int ai = 0; ai < 2; ++ai)
#pragma unroll
                for (int m = 0; m < 4; ++m) { bf16* rowp = O + (size_t)(row0 + ai * 128 + m * 16) * ldc + col0;
#pragma unroll
                    for (int bj = 0; bj < 2; ++bj) { f32x4 v0 = acc[ai][bj][m][0], v1 = acc[ai][bj][m][1];
                        if (mode == 0) {
#pragma unroll
                            for (int e = 0; e < 4; ++e) { v0[e] = silu(v0[e]) * 0.08838834764831845f; v1[e] = silu(v1[e]) * 0.08838834764831845f; }
                        } else if (mode == 3) {
#pragma unroll
                            for (int e = 0; e < 4; ++e) { v0[e] = silu(v0[e]); v1[e] = silu(v1[e]); }
                        }
                        u32x4 w; w.x = pk2(v0[0], v0[1]); w.y = pk2(v0[2], v0[3]); w.z = pk2(v1[0], v1[1]); w.w = pk2(v1[2], v1[3]);
                        *(u32x4*)(rowp + bj * 128) = w; } }
        }
        return false;
    }
};
struct EpiBranch {
    static constexpr bool PERM = true, AFTER_DRAIN = false;
    const bf16* GA; const bf16* GB; bf16* MG;
    __device__ __forceinline__ bool operator()(f32x4 (&acc)[2][2][4][2], const Unit& u, int wr, int wc, int fr, int fq) const {
        const int row0 = u.pm * 256 + wr * 64 + fr, col0 = u.pn * 256 + wc * 32 + 8 * fq;
        const bool first = (u.sel == 0);
#pragma unroll
        for (int ai = 0; ai < 2; ++ai)
#pragma unroll
            for (int m = 0; m < 4; ++m) { const size_t ro = (size_t)(row0 + ai * 128 + m * 16) * D + col0;
#pragma unroll
                for (int bj = 0; bj < 2; ++bj) {
                    const u32x4 gb = *(const u32x4*)(GB + ro + bj * 128);
                    float eb[8] = {bflo(gb.x), bfhi(gb.x), bflo(gb.y), bfhi(gb.y), bflo(gb.z), bfhi(gb.z), bflo(gb.w), bfhi(gb.w)};
#pragma unroll
                    for (int e = 0; e < 8; ++e) eb[e] = 1.0f + __expf(-eb[e]);
                    if (first) {
                        const u32x4 ga = *(const u32x4*)(GA + ro + bj * 128);
                        float ea[8] = {bflo(ga.x), bfhi(ga.x), bflo(ga.y), bfhi(ga.y), bflo(ga.z), bfhi(ga.z), bflo(ga.w), bfhi(ga.w)};
#pragma unroll
                        for (int e = 0; e < 8; ++e) { const float r = __fdividef(eb[e], 1.0f + __expf(-ea[e])); if (e < 4) acc[ai][bj][m][0][e] *= r; else acc[ai][bj][m][1][e - 4] *= r; }
                    } else {
                        float o[8];
#pragma unroll
                        for (int e = 0; e < 8; ++e) o[e] = __fdividef(e < 4 ? acc[ai][bj][m][0][e] : acc[ai][bj][m][1][e - 4], eb[e]);
                        u32x4 w; w.x = pk2(o[0], o[1]); w.y = pk2(o[2], o[3]); w.z = pk2(o[4], o[5]); w.w = pk2(o[6], o[7]);
                        *(u32x4*)(MG + ro + bj * 128) = w;
                    } } }
        return first;
    }
};
template <bool WITH_XN> struct EpiRes {
    static constexpr bool PERM = true, AFTER_DRAIN = false;
    const float* xi; float* xo; bf16* xn; const float* g; float* ss;
    __device__ __forceinline__ bool operator()(f32x4 (&acc)[2][2][4][2], const Unit& u, int wr, int wc, int fr, int fq) const {
        const int row0 = u.pm * 256 + wr * 64 + fr, col0 = u.pn * 256 + wc * 32 + 8 * fq;
        f32x4 gv[2][2];
        if (WITH_XN) {
#pragma unroll
            for (int bj = 0; bj < 2; ++bj)
#pragma unroll
                for (int n = 0; n < 2; ++n) gv[bj][n] = *(const f32x4*)(g + col0 + bj * 128 + 4 * n);
        }
#pragma unroll
        for (int ai = 0; ai < 2; ++ai)
#pragma unroll
            for (int m = 0; m < 4; ++m) { const int row = row0 + ai * 128 + m * 16; const size_t ro = (size_t)row * D + col0; float s = 0.f;
#pragma unroll
                for (int bj = 0; bj < 2; ++bj) {
                    const f32x4 v0 = acc[ai][bj][m][0] + *(const f32x4*)(xi + ro + bj * 128), v1 = acc[ai][bj][m][1] + *(const f32x4*)(xi + ro + bj * 128 + 4);
                    *(f32x4*)(xo + ro + bj * 128) = v0; *(f32x4*)(xo + ro + bj * 128 + 4) = v1;
                    s += (v0[0] * v0[0] + v0[1] * v0[1]) + (v0[2] * v0[2] + v0[3] * v0[3]) + (v1[0] * v1[0] + v1[1] * v1[1]) + (v1[2] * v1[2] + v1[3] * v1[3]);
                    if (WITH_XN) { const f32x4 a = v0 * gv[bj][0], b = v1 * gv[bj][1];
                        u32x4 w; w.x = pk2(a[0], a[1]); w.y = pk2(a[2], a[3]); w.z = pk2(b[0], b[1]); w.w = pk2(b[2], b[3]);
                        *(u32x4*)(xn + ro + bj * 128) = w; } }
                s += __shfl_xor(s, 16); s += __shfl_xor(s, 32);
                if (fq == 0) ss[(size_t)row * 16 + u.pn * 4 + wc] = s; }
        return false;
    }
};
struct EpiGU {
    static constexpr bool PERM = true, AFTER_DRAIN = false;
    const float* ss; bf16* H;
    __device__ __forceinline__ bool operator()(f32x4 (&acc)[2][2][4][2], const Unit& u, int wr, int wc, int fr, int fq) const {
        const int row0 = u.pm * 256 + wr * 64 + fr, col0 = u.pn * 128 + wc * 32 + 8 * fq;
#pragma unroll
        for (int ai = 0; ai < 2; ++ai)
#pragma unroll
            for (int m = 0; m < 4; ++m) { const int row = row0 + ai * 128 + m * 16;
                const f32x4* sp = (const f32x4*)(ss + (size_t)row * 16); const f32x4 s4 = (sp[0] + sp[1]) + (sp[2] + sp[3]);
                const float rstd = rsqrtf(((s4[0] + s4[1]) + (s4[2] + s4[3])) * (1.0f / D) + EPS);
                float o[8];
#pragma unroll
                for (int e = 0; e < 8; ++e) { const float gg = (e < 4 ? acc[ai][0][m][0][e] : acc[ai][0][m][1][e - 4]) * rstd, uu = (e < 4 ? acc[ai][1][m][0][e] : acc[ai][1][m][1][e - 4]) * rstd; o[e] = silu(gg) * uu; }
                u32x4 w; w.x = pk2(o[0], o[1]); w.y = pk2(o[2], o[3]); w.z = pk2(o[4], o[5]); w.w = pk2(o[6], o[7]);
                *(u32x4*)(H + (size_t)row * FF + col0) = w; }
        return false;
    }
};

__device__ __forceinline__ void transpose_item(const float* W, int K, int N, bf16* WT, int k0, int n0, int drow0, LAS float* scr, int lane) {
#pragma unroll 8
    for (int i = 0; i < 32; ++i) { const int kk = 2 * i + (lane >> 5); scr[kk * 33 + (lane & 31)] = W[(size_t)(k0 + kk) * N + n0 + (lane & 31)]; }
    LDS_WAIT(); asm volatile("" ::: "memory");
    const int c = lane & 7;
#pragma unroll
    for (int j = 0; j < 4; ++j) { const int n = (lane >> 3) + 8 * j; const LAS float* s = scr + (8 * c) * 33 + n;
        u32x4 o; o.x = pk2(s[0 * 33], s[1 * 33]); o.y = pk2(s[2 * 33], s[3 * 33]); o.z = pk2(s[4 * 33], s[5 * 33]); o.w = pk2(s[6 * 33], s[7 * 33]);
        *(u32x4*)(WT + (size_t)(drow0 + n) * K + k0 + 8 * c) = o; }
    LDS_WAIT(); asm volatile("" ::: "memory");
}
__device__ __forceinline__ void p0_prologue(const Args& a, LAS unsigned char* lds, int wave, int lane, int G) {
    LAS float* scr = (LAS float*)(lds + wave * 16384);
    const int gw = blockIdx.x * NWAVES + wave, NGW = G * NWAVES;
    unsigned char* ws = a.ws;
    constexpr int I_IN = (D / 64) * (NIN / 32), I_G = (D / 64) * (FF / 32), I_D = (FF / 64) * (D / 32), I_O = (D / 64) * (D / 32), I_A = (HW / 64) * (D / 32);
    constexpr int NITEMS = I_IN + 2 * I_G + I_D + I_O + 2 * I_A;
    for (int it = gw; it < NITEMS; it += NGW) {
        int r = it;
        if (r < I_IN) { const int nb = NIN / 32, kb = r / nb, n0 = 32 * (r % nb); transpose_item(a.w_in, D, NIN, (bf16*)(ws + WS_WIN), 64 * kb, n0, n0, scr, lane); continue; } r -= I_IN;
        if (r < I_G) { const int nb = FF / 32, kb = r / nb, n0 = 32 * (r % nb); transpose_item(a.w_ffn_gate, D, FF, (bf16*)(ws + WS_WGU), 64 * kb, n0, (n0 >> 7) * 256 + (n0 & 127), scr, lane); continue; } r -= I_G;
        if (r < I_G) { const int nb = FF / 32, kb = r / nb, n0 = 32 * (r % nb); transpose_item(a.w_ffn_up, D, FF, (bf16*)(ws + WS_WGU), 64 * kb, n0, (n0 >> 7) * 256 + 128 + (n0 & 127), scr, lane); continue; } r -= I_G;
        if (r < I_D) { const int nb = D / 32, kb = r / nb, n0 = 32 * (r % nb); transpose_item(a.w_ffn_down, FF, D, (bf16*)(ws + WS_WD), 64 * kb, n0, n0, scr, lane); continue; } r -= I_D;
        if (r < I_O) { const int nb = D / 32, kb = r / nb, n0 = 32 * (r % nb); transpose_item(a.w_out, D, D, (bf16*)(ws + WS_WO), 64 * kb, n0, n0, scr, lane); continue; } r -= I_O;
        if (r < I_A) { const int nb = D / 32, kb = r / nb, n0 = 32 * (r % nb); transpose_item(a.w_branch_a, HW, D, (bf16*)(ws + WS_WA), 64 * kb, n0, n0, scr, lane); continue; } r -= I_A;
        { const int nb = D / 32, kb = r / nb, n0 = 32 * (r % nb); transpose_item(a.w_branch_b, HW, D, (bf16*)(ws + WS_WB), 64 * kb, n0, n0, scr, lane); }
    }
    bf16* XN = (bf16*)a.out;
    f32x4 gm[4];
#pragma unroll
    for (int j = 0; j < 4; ++j) gm[j] = ((const f32x4*)a.norm_mix_g)[lane + 64 * j];
    for (int m = gw; m < M; m += NGW) {
        const f32x4* xr = (const f32x4*)(a.x + (size_t)m * D) + lane;
        f32x4 v[4]; float s = 0.f;
#pragma unroll
        for (int j = 0; j < 4; ++j) { v[j] = xr[64 * j]; s += (v[j].x * v[j].x + v[j].y * v[j].y) + (v[j].z * v[j].z + v[j].w * v[j].w); }
        const float rstd = rsqrtf(wave_sum(s) * (1.0f / D) + EPS);
        u32x2* o8 = (u32x2*)(XN + (size_t)m * D) + lane;
#pragma unroll
        for (int j = 0; j < 4; ++j) { const f32x4 t = v[j] * rstd * gm[j]; u32x2 w; w.x = pk2(t.x, t.y); w.y = pk2(t.z, t.w); o8[64 * j] = w; }
    }
}

constexpr int NAT_P = 272, TR_P = 80;
constexpr int L_QH = 0, L_KH = 8704, L_QI = 17408, L_KOT = 26112, L_VT = 36352, L_DEC = 46592, L_TS = 47104, L_SSQ = 49152;
#define MFMA32(a, b, c) __builtin_amdgcn_mfma_f32_32x32x16_bf16((a), (b), (c), 0, 0, 0)
__device__ __forceinline__ bf16x8 pack8(const f32x16& x, int s) {
    u32x4 p; p.x = pk2(x[8 * s + 0], x[8 * s + 1]); p.y = pk2(x[8 * s + 2], x[8 * s + 3]); p.z = pk2(x[8 * s + 4], x[8 * s + 5]); p.w = pk2(x[8 * s + 6], x[8 * s + 7]);
    return __builtin_bit_cast(bf16x8, p);
}
__device__ __forceinline__ bf16x8 cat4(s16x4 lo, s16x4 hi) { bf16x8 r; r[0] = lo[0]; r[1] = lo[1]; r[2] = lo[2]; r[3] = lo[3]; r[4] = hi[0]; r[5] = hi[1]; r[6] = hi[2]; r[7] = hi[3]; return r; }

template <bool FULL>
__device__ __forceinline__ void scan_item(const Args& a, LAS unsigned char* lds, int item, int tid, int wave, int lane) {
    unsigned char* ws = a.ws;
    const int bh = item >> 4, sc = item & 15, b = bh >> 2, h = bh & 3;
    const int row0 = b * SEQ + sc * 256;
    const int d = tid & 127, tg = tid >> 7;
    const int hf = lane >> 5, l32 = lane & 31, c = wave;
    const float* Gp = (const float*)(ws + WS_G) + (size_t)row0 * HW + h * HD + d;
    const bf16* Qp = (const bf16*)(ws + WS_Q) + (size_t)row0 * HW + h * HD + d;
    const bf16* Vp = (const bf16*)(ws + WS_V) + (size_t)row0 * HW + h * HD + d;
    float* SLOC = (float*)(ws + WS_SLOC); float* DSC = (float*)(ws + WS_DSC);
    f32x16 S[4];
#pragma unroll
    for (int a4 = 0; a4 < 4; ++a4)
#pragma unroll
        for (int r = 0; r < 16; ++r) S[a4][r] = 0.f;
    f32x4 ngv[4];
    if (FULL && wave < 4) {
        if (sc > 0) {
            const float* sl = SLOC + ((size_t)(item - 1) * 4 + c) * 4096 + lane;
#pragma unroll
            for (int a4 = 0; a4 < 4; ++a4)
#pragma unroll
                for (int r = 0; r < 16; ++r) S[a4][r] = sl[(a4 * 16 + r) * 64];
        }
#pragma unroll
        for (int rq = 0; rq < 4; ++rq) ngv[rq] = *(const f32x4*)(a.hg_norm_g + 32 * c + 8 * rq + 4 * hf);
    }
    float gl[8], ql[8], vl[8];
#pragma unroll
    for (int s = 0; s < 8; ++s) { const size_t o = (size_t)(8 * tg + s) * HW; gl[s] = Gp[o]; vl[s] = bflo((unsigned)Vp[o]); ql[s] = FULL ? bflo((unsigned)Qp[o]) : 0.f; }
    float dtot = 0.f;
    for (int ch = 0; ch < 8; ++ch) {
        float g[8], q[8], v[8];
#pragma unroll
        for (int s = 0; s < 8; ++s) { g[s] = gl[s]; q[s] = ql[s]; v[s] = vl[s]; }
        if (ch < 7) {
#pragma unroll
            for (int s = 0; s < 8; ++s) { const size_t o = (size_t)((ch + 1) * 32 + 8 * tg + s) * HW; gl[s] = Gp[o]; vl[s] = bflo((unsigned)Vp[o]); ql[s] = FULL ? bflo((unsigned)Qp[o]) : 0.f; }
        }
        u32x2 gsv[4];
        if (FULL && wave < 4) {
            const size_t ro = (size_t)(row0 + ch * 32 + l32) * HW + h * HD;
#pragma unroll
            for (int rq = 0; rq < 4; ++rq) gsv[rq] = *(const u32x2*)((const bf16*)(ws + WS_GS) + ro + 32 * c + 8 * rq + 4 * hf);
        }
        float p[8]; p[0] = g[0];
#pragma unroll
        for (int s = 1; s < 8; ++s) p[s] = p[s - 1] + g[s];
        LAS float* TS = (LAS float*)(lds + L_TS);
        TS[tg * 128 + d] = p[7];
        __syncthreads();
        const float t0 = TS[d], t1 = TS[128 + d], t2 = TS[256 + d], t3 = TS[384 + d];
        const float off = (tg > 0 ? t0 : 0.f) + (tg > 1 ? t1 : 0.f) + (tg > 2 ? t2 : 0.f);
        const float blast = (t0 + t1) + (t2 + t3), anchor = t0 + t1;
        float ko[8];
#pragma unroll
        for (int s = 0; s < 8; ++s) {
            const float bs = off + p[s], kk = 1.0f - __expf(g[s]);
            ko[s] = kk * __expf(blast - bs);
            if (FULL) {
                const int t = 8 * tg + s;
                *(LAS bf16*)(lds + L_QH + t * NAT_P + d * 2) = f2bf(q[s] * __expf(bs - anchor));
                *(LAS bf16*)(lds + L_KH + t * NAT_P + d * 2) = f2bf(kk * __expf(anchor - bs));
                *(LAS bf16*)(lds + L_QI + t * NAT_P + d * 2) = f2bf(q[s] * __expf(bs));
            }
        }
        { u32x4 w; w.x = pk2(ko[0], ko[1]); w.y = pk2(ko[2], ko[3]); w.z = pk2(ko[4], ko[5]); w.w = pk2(ko[6], ko[7]); *(LAS u32x4*)(lds + L_KOT + d * TR_P + tg * 16) = w; }
        { u32x4 w; w.x = pk2(v[0], v[1]); w.y = pk2(v[2], v[3]); w.z = pk2(v[4], v[5]); w.w = pk2(v[6], v[7]); *(LAS u32x4*)(lds + L_VT + d * TR_P + tg * 16) = w; }
        if (tg == 0) *(LAS float*)(lds + L_DEC + d * 4) = __expf(blast);
        dtot += blast;
        __syncthreads();
        f32x16 oT;
        if (wave < 4) {
            if (FULL) {
                f32x16 sT;
#pragma unroll
                for (int r = 0; r < 16; ++r) { sT[r] = 0.f; oT[r] = 0.f; }
#pragma unroll
                for (int ks = 0; ks < 8; ++ks) {
                    const bf16x8 ka = *(const LAS bf16x8*)(lds + L_KH + l32 * NAT_P + (16 * ks + 8 * hf) * 2);
                    const bf16x8 qb = *(const LAS bf16x8*)(lds + L_QH + l32 * NAT_P + (16 * ks + 8 * hf) * 2);
                    sT = MFMA32(ka, qb, sT);
                }
#pragma unroll
                for (int r = 0; r < 16; ++r) { const int j = (r & 3) + 8 * (r >> 2) + 4 * hf; if (j > l32) sT[r] = 0.f; }
#pragma unroll
                for (int ks = 0; ks < 2; ++ks) {
                    const s16x4 lo = *(const LAS s16x4*)(lds + L_VT + (32 * c + l32) * TR_P + (16 * ks + 4 * hf) * 2);
                    const s16x4 hi = *(const LAS s16x4*)(lds + L_VT + (32 * c + l32) * TR_P + (16 * ks + 8 + 4 * hf) * 2);
                    oT = MFMA32(cat4(lo, hi), pack8(sT, ks), oT);
                }
#pragma unroll
                for (int a4 = 0; a4 < 4; ++a4)
#pragma unroll
                    for (int ks = 0; ks < 2; ++ks) {
                        const s16x4 lo = *(const LAS s16x4*)(lds + L_QI + l32 * NAT_P + (32 * a4 + 16 * ks + 4 * hf) * 2);
                        const s16x4 hi = *(const LAS s16x4*)(lds + L_QI + l32 * NAT_P + (32 * a4 + 16 * ks + 8 + 4 * hf) * 2);
                        oT = MFMA32(pack8(S[a4], ks), cat4(lo, hi), oT);
                    }
            }
#pragma unroll
            for (int a4 = 0; a4 < 4; ++a4) {
#pragma unroll
                for (int rq = 0; rq < 4; ++rq) { const f32x4 dv = *(const LAS f32x4*)(lds + L_DEC + (32 * a4 + 8 * rq + 4 * hf) * 4);
#pragma unroll
                    for (int e = 0; e < 4; ++e) S[a4][4 * rq + e] *= dv[e]; }
#pragma unroll
                for (int ks = 0; ks < 2; ++ks) {
                    const bf16x8 ka = *(const LAS bf16x8*)(lds + L_KOT + (32 * a4 + l32) * TR_P + (16 * ks + 8 * hf) * 2);
                    const bf16x8 vb = *(const LAS bf16x8*)(lds + L_VT + (32 * c + l32) * TR_P + (16 * ks + 8 * hf) * 2);
                    S[a4] = MFMA32(ka, vb, S[a4]);
                }
            }
            if (FULL) {
                float ssq = 0.f;
#pragma unroll
                for (int r = 0; r < 16; ++r) ssq += oT[r] * oT[r];
                ssq += __shfl_xor(ssq, 32);
                if (lane < 32) *(LAS float*)(lds + L_SSQ + (c * 32 + l32) * 4) = ssq;
            }
        }
        if (FULL) {
            __syncthreads();
            if (wave < 4) {
                const LAS float* SQ = (const LAS float*)(lds + L_SSQ);
                const float tot = (SQ[l32] + SQ[32 + l32]) + (SQ[64 + l32] + SQ[96 + l32]);
                const float rstd = rsqrtf(tot * (1.0f / HD) + EPS);
                const size_t ro = (size_t)(row0 + ch * 32 + l32) * HW + h * HD;
#pragma unroll
                for (int rq = 0; rq < 4; ++rq) { const int dv0 = 32 * c + 8 * rq + 4 * hf;
                    const u32x2 gs = gsv[rq]; const f32x4 ng = ngv[rq];
                    const float o0 = oT[4 * rq + 0] * rstd * ng[0] * bflo(gs.x), o1 = oT[4 * rq + 1] * rstd * ng[1] * bfhi(gs.x);
                    const float o2 = oT[4 * rq + 2] * rstd * ng[2] * bflo(gs.y), o3 = oT[4 * rq + 3] * rstd * ng[3] * bfhi(gs.y);
                    u32x2 w; w.x = pk2(o0, o1); w.y = pk2(o2, o3);
                    *(u32x2*)((bf16*)(ws + WS_HG) + ro + dv0) = w; }
            }
        }
    }
    if (!FULL) {
        if (wave < 4) { float* sl = SLOC + ((size_t)item * 4 + c) * 4096 + lane;
#pragma unroll
            for (int a4 = 0; a4 < 4; ++a4)
#pragma unroll
                for (int r = 0; r < 16; ++r) sl[(a4 * 16 + r) * 64] = S[a4][r]; }
        if (tg == 0) DSC[(size_t)item * HD + d] = __expf(dtot);
    }
    __syncthreads();
}
__device__ __forceinline__ void scan_prefix(const Args& a, int tid, int G) {
    float* SLOC = (float*)(a.ws + WS_SLOC); const float* DSC = (const float*)(a.ws + WS_DSC);
    for (int e = blockIdx.x * NTHR + tid; e < 16 * 16384; e += G * NTHR) {
        const int bh = e >> 14, rem = e & 16383, idx = rem & 4095, reg = idx >> 6, ln = idx & 63;
        const int dk = 32 * (reg >> 4) + (reg & 3) + 8 * ((reg & 15) >> 2) + 4 * (ln >> 5);
        float* sp = SLOC + (size_t)bh * 16 * 16384 + rem; const float* dp = DSC + (size_t)bh * 16 * HD + dk;
        float sv[15], dv[15];
#pragma unroll
        for (int j = 0; j < 15; ++j) { sv[j] = sp[(size_t)j * 16384]; dv[j] = dp[j * HD]; }
        float S = 0.f;
#pragma unroll
        for (int j = 0; j < 15; ++j) { S = dv[j] * S + sv[j]; sp[(size_t)j * 16384] = S; }
    }
}
__device__ __forceinline__ void conv_items(const Args& a, int tid, int G) {
    unsigned char* ws = a.ws;
    const bf16* CG = (const bf16*)(ws + WS_CG); const bf16* XB = (const bf16*)(ws + WS_XB); bf16* BG = (bf16*)(ws + WS_BG);
    for (int it = blockIdx.x * NTHR + tid; it < (M / 8) * (HW / 8); it += G * NTHR) {
        const int tgp = it >> 6, c0 = (it & 63) * 8, t0 = tgp * 8;
        float w0[8], w1[8], w2[8], um2[8], um1[8];
#pragma unroll
        for (int e = 0; e < 8; ++e) { w0[e] = a.conv_w[c0 + e]; w1[e] = a.conv_w[HW + c0 + e]; w2[e] = a.conv_w[2 * HW + c0 + e]; um2[e] = 0.f; um1[e] = 0.f; }
        if ((t0 & (SEQ - 1)) != 0) {
            const u32x4 ca = *(const u32x4*)(CG + (size_t)(t0 - 2) * HW + c0), xa = *(const u32x4*)(XB + (size_t)(t0 - 2) * HW + c0);
            const u32x4 cb = *(const u32x4*)(CG + (size_t)(t0 - 1) * HW + c0), xb = *(const u32x4*)(XB + (size_t)(t0 - 1) * HW + c0);
#pragma unroll
            for (int e = 0; e < 4; ++e) { um2[2 * e] = bflo(ca[e]) * bflo(xa[e]); um2[2 * e + 1] = bfhi(ca[e]) * bfhi(xa[e]); um1[2 * e] = bflo(cb[e]) * bflo(xb[e]); um1[2 * e + 1] = bfhi(cb[e]) * bfhi(xb[e]); }
        }
#pragma unroll
        for (int s = 0; s < 8; ++s) {
            const size_t ro = (size_t)(t0 + s) * HW + c0;
            const u32x4 cc = *(const u32x4*)(CG + ro), xx = *(const u32x4*)(XB + ro), bb = *(const u32x4*)(BG + ro);
            float u[8], o[8];
#pragma unroll
            for (int e = 0; e < 4; ++e) { u[2 * e] = bflo(cc[e]) * bflo(xx[e]); u[2 * e + 1] = bfhi(cc[e]) * bfhi(xx[e]); }
#pragma unroll
            for (int e = 0; e < 8; ++e) { const float y = w0[e] * um2[e] + w1[e] * um1[e] + w2[e] * u[e]; o[e] = y * ((e & 1) ? bfhi(bb[e >> 1]) : bflo(bb[e >> 1])); um2[e] = um1[e]; um1[e] = u[e]; }
            u32x4 w; w.x = pk2(o[0], o[1]); w.y = pk2(o[2], o[3]); w.z = pk2(o[4], o[5]); w.w = pk2(o[6], o[7]);
            *(u32x4*)(BG + ro) = w;
        }
    }
}
__device__ __forceinline__ void final_norm(const Args& a, int wave, int lane, int G) {
    const float* ss = (const float*)(a.ws + WS_SS2);
    f32x4 gm[4];
#pragma unroll
    for (int j = 0; j < 4; ++j) gm[j] = ((const f32x4*)a.norm_final_g)[lane + 64 * j];
    for (int m = blockIdx.x * NWAVES + wave; m < M; m += G * NWAVES) {
        const f32x4* sp = (const f32x4*)(ss + (size_t)m * 16); const f32x4 s4 = (sp[0] + sp[1]) + (sp[2] + sp[3]);
        const float rstd = rsqrtf(((s4[0] + s4[1]) + (s4[2] + s4[3])) * (1.0f / D) + EPS);
        f32x4* xr = (f32x4*)(a.out + (size_t)m * D) + lane;
#pragma unroll
        for (int j = 0; j < 4; ++j) xr[64 * j] = xr[64 * j] * rstd * gm[j];
    }
}

__global__ void __launch_bounds__(NTHR, 2) hybrid_fwd(Args a) {
    extern __shared__ __attribute__((aligned(16))) unsigned char lds_raw[];
    LAS unsigned char* lds = (LAS unsigned char*)lds_raw;
    cg::grid_group grid = cg::this_grid();
    const int tid = threadIdx.x, lane = tid & 63, wave = __builtin_amdgcn_readfirstlane(tid >> 6), G = gridDim.x;
    unsigned char* ws = a.ws;
    unsigned* barw = (unsigned*)(ws + WS_BAR);
    if (tid < 2) ((LAS unsigned*)(lds + LDS_ST_OFF))[tid] = 0u;
    __syncthreads();
    const XcdBarrier bar = xcd_barrier_post(barw, (volatile LAS unsigned*)(lds + LDS_ST_OFF));
    if (a.coop_sync) grid.sync();
    p0_prologue(a, lds, wave, lane, G);
    xcd_barrier(bar);
    { pg8::Gemm g{(const bf16*)a.out, (const bf16*)(ws + WS_WIN), nullptr, nullptr, M, NIN, D}; pg8::StaticOrder S; S.init(M, NIN, G, (int)blockIdx.x);
      EpiProj E{ws, a.lower_bounds};
      pg8::gemm_phase<EpiProj, pg8::StaticOrder, PG8_ALIGN, PG8_SP2>(lds, g, S, E); }
    xcd_barrier(bar);
    for (int item = blockIdx.x; item < 256; item += G) scan_item<false>(a, lds, item, tid, wave, lane);
    conv_items(a, tid, G);
    xcd_barrier(bar);
    scan_prefix(a, tid, G);
    xcd_barrier(bar);
    for (int item = blockIdx.x; item < 256; item += G) scan_item<true>(a, lds, item, tid, wave, lane);
    xcd_barrier(bar);
    { pg8::Gemm g{(const bf16*)(ws + WS_HG), (const bf16*)(ws + WS_WA), (const bf16*)(ws + WS_CV), (const bf16*)(ws + WS_WB), M, D, HW}; pg8::StaticOrder S; S.init(M, D, G, (int)blockIdx.x, 1);
      EpiBranch E{(const bf16*)(ws + WS_GA), (const bf16*)(ws + WS_GB), (bf16*)(ws + WS_MG)};
      pg8::gemm_phase<EpiBranch, pg8::StaticOrder, PG8_ALIGN, PG8_SP2>(lds, g, S, E); }
    xcd_barrier(bar);
    { pg8::Gemm g{(const bf16*)(ws + WS_MG), (const bf16*)(ws + WS_WO), nullptr, nullptr, M, D, D}; pg8::StaticOrder S; S.init(M, D, G, (int)blockIdx.x);
      EpiRes<true> E{a.x, a.out, (bf16*)(ws + WS_XN2), a.norm_ffn_g, (float*)(ws + WS_SS1)};
      pg8::gemm_phase<EpiRes<true>, pg8::StaticOrder, PG8_ALIGN, PG8_SP2>(lds, g, S, E); }
    xcd_barrier(bar);
    { pg8::Gemm g{(const bf16*)(ws + WS_XN2), (const bf16*)(ws + WS_WGU), nullptr, nullptr, M, 2 * FF, D}; pg8::StaticOrder S; S.init(M, 2 * FF, G, (int)blockIdx.x);
      EpiGU E{(const float*)(ws + WS_SS1), (bf16*)(ws + WS_H)};
      pg8::gemm_phase<EpiGU, pg8::StaticOrder, PG8_ALIGN, PG8_SP2>(lds, g, S, E); }
    xcd_barrier(bar);
    { pg8::Gemm g{(const bf16*)(ws + WS_H), (const bf16*)(ws + WS_WD), nullptr, nullptr, M, D, FF}; pg8::StaticOrder S; S.init(M, D, G, (int)blockIdx.x);
      EpiRes<false> E{a.out, a.out, nullptr, nullptr, (float*)(ws + WS_SS2)};
      pg8::gemm_phase<EpiRes<false>, pg8::StaticOrder, PG8_ALIGN, PG8_SP2>(lds, g, S, E); }
    xcd_barrier(bar);
    final_norm(a, wave, lane, G);
}

extern "C" void kernel_launch(void* const* d_in, const int* in_sizes, int n_in, void* d_out, int out_size, void* d_ws, size_t ws_size, hipStream_t stream) {
    static int grid = 0;
    if (grid == 0) {
        if (n_in != 14 || out_size != M * D || ws_size < WS_END) { fprintf(stderr, "kernel_launch: unexpected shapes (n_in %d out %d ws %zu)\n", n_in, out_size, ws_size); grid = -1; return; }
        int dev = 0, cus = 0, per_cu = 0;
        (void)hipGetDevice(&dev);
        (void)hipDeviceGetAttribute(&cus, hipDeviceAttributeMultiprocessorCount, dev);
        (void)hipFuncSetAttribute((const void*)hybrid_fwd, hipFuncAttributeMaxDynamicSharedMemorySize, LDS_BYTES);
        (void)hipOccupancyMaxActiveBlocksPerMultiprocessor(&per_cu, (const void*)hybrid_fwd, NTHR, LDS_BYTES);
        if (per_cu < 1) { fprintf(stderr, "kernel_launch: occupancy query reports %d blocks per CU\n", per_cu); grid = -1; return; }
        grid = cus;
    }
    if (grid < 0) return;
    if (hipMemsetAsync((char*)d_ws + WS_BAR, 0, CTL_BYTES, stream) != hipSuccess) { fprintf(stderr, "kernel_launch: memset failed\n"); return; }
    Args a{};
    a.x = (const float*)d_in[0]; a.norm_mix_g = (const float*)d_in[1]; a.w_in = (const float*)d_in[2]; a.lower_bounds = (const float*)d_in[3]; a.hg_norm_g = (const float*)d_in[4];
    a.conv_w = (const float*)d_in[5]; a.w_branch_a = (const float*)d_in[6]; a.w_branch_b = (const float*)d_in[7]; a.w_out = (const float*)d_in[8]; a.norm_ffn_g = (const float*)d_in[9];
    a.w_ffn_gate = (const float*)d_in[10]; a.w_ffn_up = (const float*)d_in[11]; a.w_ffn_down = (const float*)d_in[12]; a.norm_final_g = (const float*)d_in[13];
    a.out = (float*)d_out; a.ws = (unsigned char*)d_ws;
    void* args[] = {&a};
    hipError_t e = hipLaunchCooperativeKernel((const void*)hybrid_fwd, dim3(grid), dim3(NTHR), args, LDS_BYTES, stream);
    if (e != hipSuccess) fprintf(stderr, "kernel_launch: cooperative launch failed: %s (grid %d)\n", hipGetErrorString(e), grid);
}
```
